# Optimizing an MI355X kernel written in HIP

```python
import math
import jax, jax.numpy as jnp
from jax import lax
import numpy as np

D_MODEL = 2048
BATCH = 4
SEQ = 8192
DEPTH = 1
DEC_BATCH = 32
DEC_SEQ = 64
PAST_LEN = 1024

CHUNK = 64
Q_BLOCK = 128
N_A = 8
DA_HEAD = 64
DA_V = 2 * DA_HEAD
N_B = 8
DB_HEAD = 128
ROT_DIM = DA_HEAD // 4
ROPE_THETA = 500000.0
D_FF = 5504
EPS = 1e-6
W_QA = N_A * 2 * DA_HEAD
W_VA = N_A * DA_V
W_B = N_B * DB_HEAD
IN_COLS = 2 * W_QA + W_VA + 3 * W_B + 2 * D_MODEL

kernel_name = "hybrid_diffattn_stickbreaking_streaming_step"


def rmsnorm(x, g):
    xf = x.astype(jnp.float32)
    y = xf * lax.rsqrt(jnp.mean(xf * xf, axis=-1, keepdims=True) + EPS)
    return (y * g.astype(jnp.float32)).astype(x.dtype)


def swiglu(x, wg, wu, wd):
    return (jax.nn.silu(x @ wg) * (x @ wu)) @ wd


def rope_partial(x, pos):
    half = ROT_DIM // 2
    inv_freq = jnp.power(ROPE_THETA, -jnp.arange(0, ROT_DIM, 2, dtype=jnp.float32) / ROT_DIM)
    ang = pos.astype(jnp.float32)[:, None] * inv_freq[None, :]
    cos = jnp.cos(ang)[None, :, None, None, :]
    sin = jnp.sin(ang)[None, :, None, None, :]
    xr = x[..., :ROT_DIM].astype(jnp.float32)
    x1, x2 = xr[..., :half], xr[..., half:]
    rot = jnp.concatenate([x1 * cos - x2 * sin, x2 * cos + x1 * sin], axis=-1)
    return jnp.concatenate([rot.astype(x.dtype), x[..., ROT_DIM:]], axis=-1)


def diff_attn(q, k, v, q_pos, k_pos, lam, subln_g, lam_init):
    b, tq = q.shape[0], q.shape[1]
    s = jnp.einsum('bqhmd,bkhmd->bhmqk', q, k).astype(jnp.float32) * (DA_HEAD ** -0.5)
    mask = (k_pos[None, :] // CHUNK) <= (q_pos[:, None] // CHUNK)
    s = jnp.where(mask[None, None, None], s, -1e30)
    p = jax.nn.softmax(s, axis=-1)
    w = p[:, :, 0] - lam * p[:, :, 1]
    o = jnp.einsum('bhqk,bkhe->bqhe', w.astype(v.dtype), v)
    o = rmsnorm(o, subln_g) * (1.0 - lam_init)
    return o.reshape(b, tq, W_VA)


def stick_breaking_attn(q, k, v, q_pos, k_pos):
    b, tq = q.shape[0], q.shape[1]
    z = jnp.einsum('bqhd,bkhd->bhqk', q, k).astype(jnp.float32) * (DB_HEAD ** -0.5)
    mask = (k_pos[None, :] < q_pos[:, None])[None, None]
    u = jnp.where(mask, jax.nn.log_sigmoid(-z), 0.0)
    rest = lax.cumsum(u, axis=3, reverse=True) - u
    a = jnp.where(mask, jnp.exp(jax.nn.log_sigmoid(z) + rest), 0.0)
    o = jnp.einsum('bhqk,bkhd->bqhd', a.astype(v.dtype), v)
    return o.reshape(b, tq, W_B)


def sweep_queries(fn, q, q_pos):
    b, t = q.shape[0], q.shape[1]
    nb = t // Q_BLOCK
    qb = q.reshape((b, nb, Q_BLOCK) + q.shape[2:]).swapaxes(0, 1)
    pb = q_pos.reshape(nb, Q_BLOCK)
    out = lax.map(lambda a: fn(a[0], a[1]), (qb, pb))
    return out.swapaxes(0, 1).reshape(b, t, out.shape[-1])


def layer(x, pos, past, blocked, lam_init, w_in, w_up_a, w_up_b, w_o, lq1, lk1, lq2, lk2, subln_g,
          n1a, n1b, nma, nmb, n2a, n2b, f1g, f1u, f1d, f2g, f2u, f2d):
    b, t, _ = x.shape
    h = x + 0.5 * rmsnorm(swiglu(rmsnorm(x, n1a), f1g, f1u, f1d), n1b)
    n = rmsnorm(h, nma)
    proj = n @ w_in
    cuts = [W_QA, 2 * W_QA, 2 * W_QA + W_VA, 2 * W_QA + W_VA + W_B,
            2 * W_QA + W_VA + 2 * W_B, 2 * W_QA + W_VA + 3 * W_B, 2 * W_QA + W_VA + 3 * W_B + D_MODEL]
    q_a, k_a, v_a, q_b, k_b, v_b, g_a, g_b = jnp.split(proj, cuts, axis=-1)
    q_a = rope_partial(q_a.reshape(b, t, N_A, 2, DA_HEAD), pos)
    k_a = rope_partial(k_a.reshape(b, t, N_A, 2, DA_HEAD), pos)
    v_a = v_a.reshape(b, t, N_A, DA_V)
    q_b = q_b.reshape(b, t, N_B, DB_HEAD)
    k_b = k_b.reshape(b, t, N_B, DB_HEAD)
    v_b = v_b.reshape(b, t, N_B, DB_HEAD)
    new_rows = (k_a, v_a, k_b, v_b)
    if past is None:
        ka_all, va_all, kb_all, vb_all, k_pos = k_a, v_a, k_b, v_b, pos
    else:
        pka, pva, pkb, pvb = past
        ka_all = jnp.concatenate([pka, k_a], axis=1)
        va_all = jnp.concatenate([pva, v_a], axis=1)
        kb_all = jnp.concatenate([pkb, k_b], axis=1)
        vb_all = jnp.concatenate([pvb, v_b], axis=1)
        k_pos = jnp.concatenate([jnp.arange(pka.shape[1], dtype=jnp.int32), pos])
    lq1f, lk1f, lq2f, lk2f = (a.astype(jnp.float32) for a in (lq1, lk1, lq2, lk2))
    lam = jnp.exp(jnp.sum(lq1f * lk1f)) - jnp.exp(jnp.sum(lq2f * lk2f)) + lam_init
    fa = lambda qq, pp: diff_attn(qq, ka_all, va_all, pp, k_pos, lam, subln_g, lam_init)
    fb = lambda qq, pp: stick_breaking_attn(qq, kb_all, vb_all, pp, k_pos)
    if blocked:
        o_a = sweep_queries(fa, q_a, pos)
        o_b = sweep_queries(fb, q_b, pos)
    else:
        o_a = fa(q_a, pos)
        o_b = fb(q_b, pos)
    merged = jax.nn.sigmoid(g_a) * (o_a @ w_up_a) + jax.nn.sigmoid(g_b) * (o_b @ w_up_b)
    h = h + rmsnorm(merged @ w_o, nmb)
    y = h + 0.5 * rmsnorm(swiglu(rmsnorm(h, n2a), f2g, f2u, f2d), n2b)
    return y, new_rows


def setup_inputs(seed: int = 0) -> dict:
    key = jax.random.key(seed)
    ks = jax.random.split(key, 32)
    f32 = jnp.float32
    nrm = lambda k, shape, s: jax.random.normal(k, shape, f32) * s
    gain = lambda k, shape: 1.0 + 0.02 * jax.random.normal(k, shape, f32)
    return {
        "x_prompt": nrm(ks[0], (BATCH, SEQ, D_MODEL), 1.0),
        "x_sample": nrm(ks[1], (DEC_BATCH, DEC_SEQ, D_MODEL), 1.0),
        "cache_diff_k": nrm(ks[2], (DEPTH, DEC_BATCH, PAST_LEN, N_A, 2, DA_HEAD), 1.0),
        "cache_diff_v": nrm(ks[3], (DEPTH, DEC_BATCH, PAST_LEN, N_A, DA_V), 1.0),
        "cache_sb_k": nrm(ks[4], (DEPTH, DEC_BATCH, PAST_LEN, N_B, DB_HEAD), 1.0),
        "cache_sb_v": nrm(ks[5], (DEPTH, DEC_BATCH, PAST_LEN, N_B, DB_HEAD), 1.0),
        "w_in": nrm(ks[6], (DEPTH, D_MODEL, IN_COLS), D_MODEL ** -0.5),
        "w_up_a": nrm(ks[7], (DEPTH, W_VA, D_MODEL), W_VA ** -0.5),
        "w_up_b": nrm(ks[8], (DEPTH, W_B, D_MODEL), W_B ** -0.5),
        "w_o": nrm(ks[9], (DEPTH, D_MODEL, D_MODEL), D_MODEL ** -0.5),
        "lam_q1": nrm(ks[10], (DEPTH, DA_HEAD), 0.1),
        "lam_k1": nrm(ks[11], (DEPTH, DA_HEAD), 0.1),
        "lam_q2": nrm(ks[12], (DEPTH, DA_HEAD), 0.1),
        "lam_k2": nrm(ks[13], (DEPTH, DA_HEAD), 0.1),
        "subln_g": gain(ks[14], (DEPTH, DA_V)),
        "norm_ffn1_pre": gain(ks[15], (DEPTH, D_MODEL)),
        "norm_ffn1_post": gain(ks[16], (DEPTH, D_MODEL)),
        "norm_mix_pre": gain(ks[17], (DEPTH, D_MODEL)),
        "norm_mix_post": gain(ks[18], (DEPTH, D_MODEL)),
        "norm_ffn2_pre": gain(ks[19], (DEPTH, D_MODEL)),
        "norm_ffn2_post": gain(ks[20], (DEPTH, D_MODEL)),
        "ffn1_w_gate": nrm(ks[21], (DEPTH, D_MODEL, D_FF), D_MODEL ** -0.5),
        "ffn1_w_up": nrm(ks[22], (DEPTH, D_MODEL, D_FF), D_MODEL ** -0.5),
        "ffn1_w_down": nrm(ks[23], (DEPTH, D_FF, D_MODEL), D_FF ** -0.5),
        "ffn2_w_gate": nrm(ks[24], (DEPTH, D_MODEL, D_FF), D_MODEL ** -0.5),
        "ffn2_w_up": nrm(ks[25], (DEPTH, D_MODEL, D_FF), D_MODEL ** -0.5),
        "ffn2_w_down": nrm(ks[26], (DEPTH, D_FF, D_MODEL), D_FF ** -0.5),
    }


def reference(x_prompt, x_sample, cache_diff_k, cache_diff_v, cache_sb_k, cache_sb_v,
              w_in, w_up_a, w_up_b, w_o, lam_q1, lam_k1, lam_q2, lam_k2, subln_g,
              norm_ffn1_pre, norm_ffn1_post, norm_mix_pre, norm_mix_post, norm_ffn2_pre, norm_ffn2_post,
              ffn1_w_gate, ffn1_w_up, ffn1_w_down, ffn2_w_gate, ffn2_w_up, ffn2_w_down):
    pos_p = jnp.arange(x_prompt.shape[1], dtype=jnp.int32)
    pos_s = cache_diff_k.shape[2] + jnp.arange(x_sample.shape[1], dtype=jnp.int32)
    hp, hs = x_prompt, x_sample
    rows_p, rows_s = [], []
    for l in range(DEPTH):
        lam_init = 0.8 - 0.6 * math.exp(-0.3 * l)
        params = (w_in[l], w_up_a[l], w_up_b[l], w_o[l], lam_q1[l], lam_k1[l], lam_q2[l], lam_k2[l], subln_g[l],
                  norm_ffn1_pre[l], norm_ffn1_post[l], norm_mix_pre[l], norm_mix_post[l],
                  norm_ffn2_pre[l], norm_ffn2_post[l],
                  ffn1_w_gate[l], ffn1_w_up[l], ffn1_w_down[l], ffn2_w_gate[l], ffn2_w_up[l], ffn2_w_down[l])
        hp, rp = layer(hp, pos_p, None, True, lam_init, *params)
        past = (cache_diff_k[l], cache_diff_v[l], cache_sb_k[l], cache_sb_v[l])
        hs, rs = layer(hs, pos_s, past, False, lam_init, *params)
        rows_p.append(rp)
        rows_s.append(rs)
    pk_a = jnp.stack([r[0] for r in rows_p])
    pv_a = jnp.stack([r[1] for r in rows_p])
    pk_b = jnp.stack([r[2] for r in rows_p])
    pv_b = jnp.stack([r[3] for r in rows_p])
    sk_a = jnp.stack([r[0] for r in rows_s])
    sv_a = jnp.stack([r[1] for r in rows_s])
    sk_b = jnp.stack([r[2] for r in rows_s])
    sv_b = jnp.stack([r[3] for r in rows_s])
    return (hp, hs, pk_a, pv_a, pk_b, pv_b, sk_a, sv_a, sk_b, sv_b)
```

```cpp
#include <hip/hip_runtime.h>
#include <cstdio>
#include <cstdint>
#define SAMPLE_DIFF_NAIVE 1
namespace pg8 {
#define PG8_LAS __attribute__((address_space(3)))
typedef unsigned short bf16_t;
typedef short bf16x8 __attribute__((ext_vector_type(8)));
typedef float f32x4 __attribute__((ext_vector_type(4)));
typedef unsigned u32x4 __attribute__((ext_vector_type(4)));
constexpr int BM = 256, BK = 64, HALF = 128, HTB = HALF * BK * 2  , STAGE_BYTES = 8 * HTB, NXCD = 8, WGM = 8;

__host__ __device__ __forceinline__ int lds_byte(int r, int c) { const int st = (r >> 4) * 2 + (c >> 5), rr = r & 15, cc = c & 31, ob = rr * 64 + cc * 2; return st * 1024 + (ob ^ (((ob >> 9) & 1) << 5)); }
__host__ __device__ __forceinline__ void stage_rc(int b, int& R, int& C) { const int st = b / 1024, sb = b % 1024, swz = sb ^ (((sb >> 9) & 1) << 5); R = (st >> 1) * 16 + swz / 64; C = (st & 1) * 32 + (swz % 64) / 2; }
__host__ __device__ __forceinline__ int perm32(int rho) { const int n = rho >> 4, i = rho & 15; return 8 * (i >> 2) + 4 * n + (i & 3); }

struct Unit { int pm, pn; };
struct Gemm { const bf16_t* A; const bf16_t* Bt; int M, N, K; };

struct StaticOrder {
    int nM, nN, nwg, G, c;
    __host__ __device__ void init(int M, int N, int G_, int c_) { nM = M / BM; nN = N / BM; nwg = nM * nN; G = G_; c = c_; }
    __host__ __device__ bool next(int i, Unit& u) const {
        const long L = (long)i * G + c; if (L >= nwg) return false;
        int wgid = (int)L; { const int q = nwg / NXCD, r = nwg % NXCD, xcd = wgid % NXCD, off = wgid / NXCD; wgid = (xcd < r ? xcd * (q + 1) : r * (q + 1) + (xcd - r) * q) + off; }
        const int nig = WGM * nN, gid = wgid / nig, fm = gid * WGM, gsz = (nM - fm) < WGM ? (nM - fm) : WGM;
        u.pm = fm + ((wgid % nig) % gsz); u.pn = (wgid % nig) / gsz; return true;
    }
    __device__ __forceinline__ void a_ready(const Unit&) const {}
    __device__ __forceinline__ void done(const Unit&) const {}
};

__device__ __forceinline__ unsigned cvt_pk_bf16(float lo, float hi) { unsigned r; asm volatile("v_cvt_pk_bf16_f32 %0, %1, %2" : "=v"(r) : "v"(lo), "v"(hi)); return r; }
__device__ __forceinline__ u32x4 pack8(const f32x4 v0, const f32x4 v1) { u32x4 w; w.x = cvt_pk_bf16(v0[0], v0[1]); w.y = cvt_pk_bf16(v0[2], v0[3]); w.z = cvt_pk_bf16(v1[0], v1[1]); w.w = cvt_pk_bf16(v1[2], v1[3]); return w; }
__device__ __forceinline__ float bf_lo(unsigned w) { return __uint_as_float(w << 16); }
__device__ __forceinline__ float bf_hi(unsigned w) { return __uint_as_float(w & 0xffff0000u); }
__device__ __forceinline__ float sigmoid_f(float x) { return __builtin_amdgcn_rcpf(1.0f + __builtin_amdgcn_exp2f(-1.4426950408889634f * x)); }

struct EpiPlain {
    static constexpr bool PERM = true, AFTER_DRAIN = false;
    bf16_t* O; int ldc;
    __device__ __forceinline__ void operator()(const f32x4 (&acc)[2][2][4][2], const Unit& u, int wr, int wc, int fr, int fq) const {
        const int row0 = u.pm * BM + wr * 64 + fr, col0 = u.pn * BM + wc * 32 + 8 * fq;
#pragma unroll
        for (int ai = 0; ai < 2; ++ai)
#pragma unroll
            for (int m = 0; m < 4; ++m) { bf16_t* rowp = O + (size_t)(row0 + ai * HALF + m * 16) * ldc + col0;
#pragma unroll
                for (int bj = 0; bj < 2; ++bj) *(u32x4*)(rowp + bj * HALF) = pack8(acc[ai][bj][m][0], acc[ai][bj][m][1]); }
    }
};
struct EpiSwiGLU {
    static constexpr bool PERM = true, AFTER_DRAIN = false;
    bf16_t* O; int ldc;
    __device__ __forceinline__ void operator()(const f32x4 (&acc)[2][2][4][2], const Unit& u, int wr, int wc, int fr, int fq) const {
        const int row0 = u.pm * BM + wr * 64 + fr, col0 = u.pn * HALF + wc * 32 + 8 * fq;
#pragma unroll
        for (int ai = 0; ai < 2; ++ai)
#pragma unroll
            for (int m = 0; m < 4; ++m) { bf16_t* rowp = O + (size_t)(row0 + ai * HALF + m * 16) * ldc + col0;
                f32x4 v[2];
#pragma unroll
                for (int n = 0; n < 2; ++n)
#pragma unroll
                    for (int i = 0; i < 4; ++i) { const float g = acc[ai][0][m][n][i], up = acc[ai][1][m][n][i]; v[n][i] = g * sigmoid_f(g) * up; }
                *(u32x4*)rowp = pack8(v[0], v[1]); }
    }
};
struct EpiWin {
    static constexpr bool PERM = true, AFTER_DRAIN = false;
    bf16_t *QA, *KA, *VA, *QB, *KB, *VB, *SGA, *SGB;
    float *okA_p, *ovA_p, *okB_p, *ovB_p, *okA_s, *ovA_s, *okB_s, *ovB_s;
    const float* rope;
    float cqa, cqb;
    __device__ __forceinline__ void operator()(const f32x4 (&acc)[2][2][4][2], const Unit& u, int wr, int wc, int fr, int fq) const {
        const int pn = u.pn, lane = (int)(threadIdx.x & 63u);
        int seg, ct; if (pn < 24) { seg = pn >> 2; ct = pn & 3; } else if (pn < 32) { seg = 6; ct = pn - 24; } else { seg = 7; ct = pn - 32; }
        const bool prompt = u.pm < 128;
        const int row0 = u.pm * BM + wr * 64 + fr, col0 = ct * BM + wc * 32 + 8 * fq;
        bf16_t* bdst; float* fdst = nullptr; int ld = 1024; float scale = 1.f;
        switch (seg) {
            case 0: bdst = QA; scale = cqa; break;
            case 1: bdst = KA; fdst = prompt ? okA_p : okA_s; break;
            case 2: bdst = VA; fdst = prompt ? ovA_p : ovA_s; break;
            case 3: bdst = QB; scale = cqb; break;
            case 4: bdst = KB; fdst = prompt ? okB_p : okB_s; break;
            case 5: bdst = VB; fdst = prompt ? ovB_p : ovB_s; break;
            case 6: bdst = SGA; ld = 2048; break;
            default: bdst = SGB; ld = 2048; break;
        }
        const bool dorope = (seg <= 1) && ((wc & 1) == 0);
        const bool gate = seg >= 6;
        const float sgn = (fq == 0) ? -1.f : 1.f;
#pragma unroll
        for (int ai = 0; ai < 2; ++ai)
#pragma unroll
            for (int m = 0; m < 4; ++m) {
                const int row = row0 + ai * HALF + m * 16;
                f32x4 v[2][2];
#pragma unroll
                for (int bj = 0; bj < 2; ++bj) { v[bj][0] = acc[ai][bj][m][0]; v[bj][1] = acc[ai][bj][m][1]; }
                if (dorope) {
                    const int pos = prompt ? (row & 8191) : (1024 + (row & 63));
                    const f32x4 c0 = *(const f32x4*)(rope + pos * 16), c1 = *(const f32x4*)(rope + pos * 16 + 4), s0 = *(const f32x4*)(rope + pos * 16 + 8), s1 = *(const f32x4*)(rope + pos * 16 + 12);
#pragma unroll
                    for (int bj = 0; bj < 2; ++bj)
#pragma unroll
                        for (int i = 0; i < 4; ++i) {
                            const float a0 = v[bj][0][i], a1 = v[bj][1][i];
                            const float p0 = __shfl_xor(a0, 16), p1 = __shfl_xor(a1, 16);
                            const float r0 = a0 * c0[i] + sgn * p0 * s0[i], r1 = a1 * c1[i] + sgn * p1 * s1[i];
                            if (fq < 2) { v[bj][0][i] = r0; v[bj][1][i] = r1; }
                        }
                }
                if (fdst) { float* fp = fdst + (size_t)(prompt ? row : row - 32768) * 1024 + col0;
#pragma unroll
                    for (int bj = 0; bj < 2; ++bj) { *(f32x4*)(fp + bj * HALF) = v[bj][0]; *(f32x4*)(fp + bj * HALF + 4) = v[bj][1]; } }
                bf16_t* bp = bdst + (size_t)row * ld + col0;
#pragma unroll
                for (int bj = 0; bj < 2; ++bj) {
                    f32x4 a = v[bj][0], b = v[bj][1];
                    if (gate) {
#pragma unroll
                        for (int i = 0; i < 4; ++i) { a[i] = sigmoid_f(a[i]); b[i] = sigmoid_f(b[i]); }
                    } else { a = a * scale; b = b * scale; }
                    *(u32x4*)(bp + bj * HALF) = pack8(a, b);
                }
            }
        (void)lane;
    }
};
struct EpiUpGate {
    static constexpr bool PERM = true, AFTER_DRAIN = false;
    const bf16_t *SGA, *SGB; bf16_t* MG;
    __device__ __forceinline__ void operator()(const f32x4 (&acc)[2][2][4][2], const Unit& u, int wr, int wc, int fr, int fq) const {
        const bool br = u.pm >= 136; const int pm = br ? u.pm - 136 : u.pm, pn = br ? u.pn - 8 : u.pn;
        const bf16_t* sg = br ? SGB : SGA;
        const int row0 = pm * BM + wr * 64 + fr, col0 = pn * BM + wc * 32 + 8 * fq;
#pragma unroll
        for (int ai = 0; ai < 2; ++ai)
#pragma unroll
            for (int m = 0; m < 4; ++m) { const size_t off = (size_t)(row0 + ai * HALF + m * 16) * 2048 + col0;
#pragma unroll
                for (int bj = 0; bj < 2; ++bj) {
                    const u32x4 g = *(const u32x4*)(sg + off + bj * HALF);
                    f32x4 a = acc[ai][bj][m][0], b = acc[ai][bj][m][1];
                    a[0] *= bf_lo(g.x); a[1] *= bf_hi(g.x); a[2] *= bf_lo(g.y); a[3] *= bf_hi(g.y);
                    b[0] *= bf_lo(g.z); b[1] *= bf_hi(g.z); b[2] *= bf_lo(g.w); b[3] *= bf_hi(g.w);
                    if (br) { const u32x4 p = *(const u32x4*)(MG + off + bj * HALF);
                        a[0] += bf_lo(p.x); a[1] += bf_hi(p.x); a[2] += bf_lo(p.y); a[3] += bf_hi(p.y);
                        b[0] += bf_lo(p.z); b[1] += bf_hi(p.z); b[2] += bf_lo(p.w); b[3] += bf_hi(p.w); }
                    *(u32x4*)(MG + off + bj * HALF) = pack8(a, b);
                } }
    }
};
struct UpOrder {
    StaticOrder so;
    __device__ void init(int G_, int c_) { so.init(136 * BM, 8 * BM, G_, c_); }
    __device__ bool next(int i, Unit& u) const { if (!so.next(i >> 1, u)) return false; if (i & 1) { u.pm += 136; u.pn += 8; } return true; }
    __device__ __forceinline__ void a_ready(const Unit&) const {}
    __device__ __forceinline__ void done(const Unit&) const {}
};

template <class Epi, class Sched, bool ALIGN_EPI = false, bool SP2 = false>
__device__ __forceinline__ void gemm_phase(PG8_LAS unsigned char* lds, const Gemm g, const Sched& S, const Epi& E) {
    const int tid = threadIdx.x, wid = __builtin_amdgcn_readfirstlane(tid >> 6), lane = tid & 63, wr = wid >> 2, wc = wid & 3, fr = lane & 15, fq = lane >> 4;
    const int K = g.K, nt = K / BK;
    unsigned voffA[2], voffB[2];
#pragma unroll
    for (int i = 0; i < 2; ++i) { int R, C; stage_rc(tid * 16 + i * 8192, R, C); const int Rb = Epi::PERM ? ((R & ~31) + perm32(R & 31)) : R;
        voffA[i] = (unsigned)(R * K + C) * 2u; voffB[i] = (unsigned)(Rb * K + C) * 2u; }
    const size_t kstep = (size_t)(BK * 2);
    const size_t hstep = (size_t)HALF * K * 2;
    const size_t tstep = 2 * hstep;
    const unsigned ldsw = (unsigned)wid * 1024u;
    const int aoff = lds_byte(wr * 64 + fr, fq * 8), boff = lds_byte(wc * 32 + fr, fq * 8);
#define PG8_SA(b, h) (((b) * 2 + (h)) * HTB)
#define PG8_SB(b, h) ((4 + (b) * 2 + (h)) * HTB)
#define PG8_STAGE(bufoff, gbase, voff) do { _Pragma("unroll") for (int _i = 0; _i < 2; ++_i) \
        __builtin_amdgcn_global_load_lds((const unsigned*)((const char*)(gbase) + (voff)[_i]), (PG8_LAS unsigned*)(lds + (bufoff) + ldsw + _i * 8192), 16, 0, 0); } while (0)
#define PG8_LDA(dst, b, h) do { _Pragma("unroll") for (int m = 0; m < 4; ++m) _Pragma("unroll") for (int k = 0; k < 2; ++k) dst[m][k] = *(const PG8_LAS bf16x8*)(lds + PG8_SA(b, h) + aoff + m * 2048 + k * 1024); } while (0)
#define PG8_LDB(dst, b, h) do { _Pragma("unroll") for (int n = 0; n < 2; ++n) _Pragma("unroll") for (int k = 0; k < 2; ++k) dst[n][k] = *(const PG8_LAS bf16x8*)(lds + PG8_SB(b, h) + boff + n * 2048 + k * 1024); } while (0)
#define PG8_MMA(ai, bj, At, Bt) do { __builtin_amdgcn_s_setprio(1); _Pragma("unroll") for (int m = 0; m < 4; ++m) _Pragma("unroll") for (int n = 0; n < 2; ++n) _Pragma("unroll") for (int k = 0; k < 2; ++k) \
        acc[ai][bj][m][n] = __builtin_amdgcn_mfma_f32_16x16x32_bf16(Bt[n][k], At[m][k], acc[ai][bj][m][n], 0, 0, 0); __builtin_amdgcn_s_setprio(0); } while (0)
#define PG8_WAIT_V(n) asm volatile("s_waitcnt vmcnt(" #n ")" ::: "memory")
#define PG8_WAIT_L(n) asm volatile("s_waitcnt lgkmcnt(" #n ")" ::: "memory")
#define PG8_BAR __builtin_amdgcn_s_barrier()
#define PG8_SCHED __builtin_amdgcn_sched_barrier(0)
    Unit cur, nxt; int ui = 0;
    if (!S.next(0, cur)) return;
    f32x4 acc[2][2][4][2];
#pragma unroll
    for (int a = 0; a < 2; ++a)
#pragma unroll
        for (int b = 0; b < 2; ++b)
#pragma unroll
            for (int m = 0; m < 4; ++m)
#pragma unroll
                for (int n = 0; n < 2; ++n) acc[a][b][m][n] = (f32x4){0.f, 0.f, 0.f, 0.f};
    bf16x8 At[4][2], B0[2][2], B1[2][2];
    const char* cA = (const char*)g.A + (size_t)cur.pm * tstep; const char* cB = (const char*)g.Bt + (size_t)cur.pn * tstep;
    S.a_ready(cur);
    if constexpr (SP2) {
        PG8_STAGE(PG8_SB(0, 0), cB, voffB); PG8_STAGE(PG8_SB(0, 1), cB + hstep, voffB); PG8_STAGE(PG8_SA(0, 0), cA, voffA); PG8_STAGE(PG8_SA(0, 1), cA + hstep, voffA);
        if (wr == 1) PG8_BAR;
        PG8_WAIT_V(2); PG8_BAR;
        PG8_STAGE(PG8_SB(1, 0), cB + kstep, voffB); PG8_STAGE(PG8_SA(1, 0), cA + kstep, voffA); PG8_STAGE(PG8_SB(1, 1), cB + hstep + kstep, voffB);
        PG8_WAIT_V(6); PG8_BAR;
    } else {
        PG8_STAGE(PG8_SB(0, 0), cB, voffB); PG8_STAGE(PG8_SA(0, 0), cA, voffA); PG8_STAGE(PG8_SB(0, 1), cB + hstep, voffB); PG8_STAGE(PG8_SA(0, 1), cA + hstep, voffA);
        if (wr == 1) PG8_BAR;
        PG8_WAIT_V(4); PG8_BAR;
        PG8_STAGE(PG8_SB(1, 0), cB + kstep, voffB); PG8_STAGE(PG8_SA(1, 0), cA + kstep, voffA); PG8_STAGE(PG8_SB(1, 1), cB + hstep + kstep, voffB);
        PG8_WAIT_V(6); PG8_BAR;
    }
    for (;;) {
        const bool has_next = S.next(ui + 1, nxt);
        const char* nA = has_next ? (const char*)g.A + (size_t)nxt.pm * tstep : cA; const char* nB = has_next ? (const char*)g.Bt + (size_t)nxt.pn * tstep : cB;
        for (int t = 0; t < nt; t += 2) {
            const bool last = (t == nt - 2);
            const char* a1 = cA + (size_t)(t + 1) * kstep;
            const char* a2 = last ? nA : cA + (size_t)(t + 2) * kstep; const char* b2 = last ? nB : cB + (size_t)(t + 2) * kstep;
            const char* a3 = a2 + kstep; const char* b3 = b2 + kstep;
            if (last && has_next) S.a_ready(nxt);
            if constexpr (SP2) {
            PG8_LDB(B0, 0, 0); PG8_LDB(B1, 0, 1); PG8_SCHED; PG8_LDA(At, 0, 0); PG8_STAGE(PG8_SA(1, 1), a1 + hstep, voffA);
            PG8_WAIT_V(8); PG8_WAIT_L(0); PG8_BAR; PG8_MMA(0, 0, At, B0); PG8_MMA(0, 1, At, B1); PG8_BAR; PG8_SCHED;
            PG8_LDA(At, 0, 1); PG8_STAGE(PG8_SB(0, 0), b2, voffB); PG8_STAGE(PG8_SB(0, 1), b2 + hstep, voffB); PG8_STAGE(PG8_SA(0, 0), a2, voffA);
            PG8_WAIT_V(8); PG8_WAIT_L(0); PG8_BAR; PG8_MMA(1, 0, At, B0); PG8_MMA(1, 1, At, B1); PG8_BAR; PG8_SCHED;
            PG8_LDB(B0, 1, 0); PG8_LDB(B1, 1, 1); PG8_SCHED; PG8_LDA(At, 1, 0); PG8_STAGE(PG8_SA(0, 1), a2 + hstep, voffA);
            PG8_WAIT_V(8); PG8_WAIT_L(0); PG8_BAR; PG8_MMA(0, 0, At, B0); PG8_MMA(0, 1, At, B1); PG8_BAR; PG8_SCHED;
            PG8_LDA(At, 1, 1); PG8_STAGE(PG8_SB(1, 0), b3, voffB); PG8_STAGE(PG8_SB(1, 1), b3 + hstep, voffB); PG8_STAGE(PG8_SA(1, 0), a3, voffA);
            PG8_WAIT_V(8); PG8_WAIT_L(0); PG8_BAR; PG8_MMA(1, 0, At, B0); PG8_MMA(1, 1, At, B1); PG8_BAR; PG8_SCHED;
            } else {
            PG8_LDB(B0, 0, 0); PG8_SCHED; PG8_LDA(At, 0, 0); PG8_STAGE(PG8_SA(1, 1), a1 + hstep, voffA);
            PG8_WAIT_L(8); PG8_BAR; PG8_WAIT_L(0); PG8_MMA(0, 0, At, B0); PG8_BAR; PG8_SCHED;
            PG8_LDB(B1, 0, 1); PG8_STAGE(PG8_SB(0, 0), b2, voffB);
            PG8_BAR; PG8_WAIT_L(0); PG8_MMA(0, 1, At, B1); PG8_BAR;
            PG8_LDA(At, 0, 1); PG8_STAGE(PG8_SA(0, 0), a2, voffA);
            PG8_BAR; PG8_WAIT_L(0); PG8_MMA(1, 0, At, B0); PG8_BAR; PG8_SCHED;
            PG8_STAGE(PG8_SB(0, 1), b2 + hstep, voffB);
            PG8_WAIT_V(6); PG8_BAR; PG8_MMA(1, 1, At, B1); PG8_BAR;
            PG8_LDB(B0, 1, 0); PG8_SCHED; PG8_LDA(At, 1, 0); PG8_STAGE(PG8_SA(0, 1), a2 + hstep, voffA);
            PG8_WAIT_L(8); PG8_BAR; PG8_WAIT_L(0); PG8_MMA(0, 0, At, B0); PG8_BAR; PG8_SCHED;
            PG8_LDB(B1, 1, 1); PG8_STAGE(PG8_SB(1, 0), b3, voffB);
            PG8_BAR; PG8_WAIT_L(0); PG8_MMA(0, 1, At, B1); PG8_BAR;
            PG8_LDA(At, 1, 1); PG8_STAGE(PG8_SA(1, 0), a3, voffA);
            PG8_BAR; PG8_WAIT_L(0); PG8_MMA(1, 0, At, B0); PG8_BAR; PG8_SCHED;
            PG8_STAGE(PG8_SB(1, 1), b3 + hstep, voffB);
            PG8_WAIT_V(6); PG8_BAR; PG8_MMA(1, 1, At, B1); PG8_BAR;
            }
        }
        if constexpr (ALIGN_EPI) { if (wr == 0) PG8_BAR; }
        if constexpr (!Epi::AFTER_DRAIN) { E(acc, cur, wr, wc, fr, fq); S.done(cur); }
        if (!has_next) break;
#pragma unroll
        for (int a = 0; a < 2; ++a)
#pragma unroll
            for (int b = 0; b < 2; ++b)
#pragma unroll
                for (int m = 0; m < 4; ++m)
#pragma unroll
                    for (int n = 0; n < 2; ++n) acc[a][b][m][n] = (f32x4){0.f, 0.f, 0.f, 0.f};
        cur = nxt; cA = nA; cB = nB; ++ui;
        if constexpr (ALIGN_EPI) { if (wr == 1) PG8_BAR; }
    }
    PG8_WAIT_V(0);
    if constexpr (!ALIGN_EPI) { if (wr == 0) PG8_BAR; }
    PG8_BAR;
    if constexpr (Epi::AFTER_DRAIN) { E.fused(acc, cur, wr, wc, fr, fq, lds, wid, lane); S.done(cur); }
#undef PG8_SA
#undef PG8_SB
#undef PG8_STAGE
#undef PG8_LDA
#undef PG8_LDB
#undef PG8_MMA
#undef PG8_WAIT_V
#undef PG8_WAIT_L
#undef PG8_BAR
#undef PG8_SCHED
}
}
namespace att {
typedef unsigned short bf16;
using bf16x8 = __attribute__((ext_vector_type(8))) short;
using s16x4  = __attribute__((ext_vector_type(4))) short;
using f32x16 = __attribute__((ext_vector_type(16))) float;
using f32x8  = __attribute__((ext_vector_type(8))) float;
using f32x4  = __attribute__((ext_vector_type(4))) float;
using u32x4  = __attribute__((ext_vector_type(4))) unsigned;
constexpr int NW = 8, QBLK = 32, KVBLK = 64, LD = 1024;
constexpr size_t SHM_V = KVBLK * 128 * 2, SHM_K = KVBLK * 128 * 2, SHM_ATTN = 2 * SHM_V + 2 * SHM_K + NW * 64 * 4;
constexpr float THR2 = 11.0f;
#define KSWZ(row, colB) ((row) * 256 + ((colB) ^ (((row) & 7) << 4)))
#define SBAR() __builtin_amdgcn_sched_barrier(0)
__device__ __forceinline__ int crow(int r, int hi) { return (r & 3) + 8 * (r >> 2) + 4 * hi; }
__device__ __forceinline__ unsigned cvtpk(float lo, float hi) { unsigned r; asm volatile("v_cvt_pk_bf16_f32 %0, %1, %2" : "=v"(r) : "v"(lo), "v"(hi)); return r; }
template <typename TIn> struct Stage;
template <> struct Stage<bf16>  { using T = bf16x8;
  __device__ static __forceinline__ T ld8(const bf16* p) { return *reinterpret_cast<const bf16x8*>(p); }
  __device__ static __forceinline__ bf16x8 tobf(T x) { return x; } };
template <> struct Stage<float> { using T = bf16x8;
  __device__ static __forceinline__ T ld8(const float* p) { const f32x8 x = *reinterpret_cast<const f32x8*>(p);
    u32x4 w = {cvtpk(x[0], x[1]), cvtpk(x[2], x[3]), cvtpk(x[4], x[5]), cvtpk(x[6], x[7])}; return *reinterpret_cast<bf16x8*>(&w); }
  __device__ static __forceinline__ bf16x8 tobf(T x) { return x; } };
struct KVLin { typedef bf16 T; const bf16* k0; const bf16* v0;
  __device__ __forceinline__ const bf16* krow(int k) const { return k0 + (size_t)k * LD; }
  __device__ __forceinline__ const bf16* vrow(int k) const { return v0 + (size_t)k * LD; } };
struct KVTwo { typedef float T; const float* k0; const float* v0; const float* k1; const float* v1; int n0;
  __device__ __forceinline__ const float* krow(int k) const { return k < n0 ? k0 + (size_t)k * LD : k1 + (size_t)((k - n0) & 63) * LD; }
  __device__ __forceinline__ const float* vrow(int k) const { return k < n0 ? v0 + (size_t)k * LD : v1 + (size_t)((k - n0) & 63) * LD; } };

#define PK4(P, BASE, OUT) do { unsigned a0 = cvtpk(P[BASE + 0], P[BASE + 1]), a1 = cvtpk(P[BASE + 2], P[BASE + 3]);   \
    unsigned b0 = cvtpk(P[BASE + 4], P[BASE + 5]), b1 = cvtpk(P[BASE + 6], P[BASE + 7]);                              \
    auto r0 = __builtin_amdgcn_permlane32_swap(a0, b0, false, false); auto r1 = __builtin_amdgcn_permlane32_swap(a1, b1, false, false); \
    u32x4 w = {r0[0], r1[0], r0[1], r1[1]}; OUT = *reinterpret_cast<bf16x8*>(&w); } while (0)

__device__ __forceinline__ void partialSM(f32x16& p0, f32x16& p1, float& m_reg, float& alpha) {
  float pmax = p0[0];
#pragma unroll
  for (int r = 1; r < 16; ++r) pmax = fmaxf(pmax, p0[r]);
#pragma unroll
  for (int r = 0; r < 16; ++r) pmax = fmaxf(pmax, p1[r]);
  { auto rr = __builtin_amdgcn_permlane32_swap(__float_as_uint(pmax), __float_as_uint(pmax), false, false);
    pmax = fmaxf(__uint_as_float(rr[0]), __uint_as_float(rr[1])); }
  float mn;
  if (__builtin_expect(__all(pmax - m_reg <= THR2), 1)) { mn = m_reg; alpha = 1.f; }
  else { mn = fmaxf(m_reg, pmax); alpha = __builtin_amdgcn_exp2f(m_reg - mn); m_reg = mn; }
#pragma unroll
  for (int r = 0; r < 16; ++r) p0[r] = p0[r] - mn;
#pragma unroll
  for (int r = 0; r < 16; ++r) p1[r] = p1[r] - mn;
#pragma unroll
  for (int r = 0; r < 16; ++r) p0[r] = __builtin_amdgcn_exp2f(p0[r]);
}
__device__ __forceinline__ void finishSM(f32x16& p0, f32x16& p1, float alpha, float& l_reg, bf16x8& pa0, bf16x8& pa1, bf16x8& pa2, bf16x8& pa3) {
#pragma unroll
  for (int r = 0; r < 16; ++r) p1[r] = __builtin_amdgcn_exp2f(p1[r]);
  float ps = 0;
#pragma unroll
  for (int r = 0; r < 16; ++r) ps += p0[r];
#pragma unroll
  for (int r = 0; r < 16; ++r) ps += p1[r];
  { auto rr = __builtin_amdgcn_permlane32_swap(__float_as_uint(ps), __float_as_uint(ps), false, false);
    ps = __uint_as_float(rr[0]) + __uint_as_float(rr[1]); }
  l_reg = l_reg * alpha + ps;
  PK4(p0, 0, pa0); PK4(p0, 8, pa1); PK4(p1, 0, pa2); PK4(p1, 8, pa3);
}
#define SBGRP(P, B, kb, T) do { float z_[4], s_[4];                                                                          \
    _Pragma("unroll") for (int k_ = 0; k_ < 4; ++k_) { const float zz = P[(B) + k_];                                           \
      const float e_ = __builtin_amdgcn_exp2f(-__builtin_fabsf(zz)); const float l_ = __builtin_amdgcn_logf(1.0f + e_);        \
      float u_ = -(fmaxf(zz, 0.f) + l_); float zk = zz;                                                                         \
      if (needmask) { const bool msk_ = (kbase + (kb) + k_) >= qrow; u_ = msk_ ? 0.f : u_; zk = msk_ ? -INFINITY : zk; }        \
      z_[k_] = zk; s_[k_] = u_; }                                                                                               \
    s_[2] += s_[3]; s_[1] += s_[2]; s_[0] += s_[1]; T = s_[0];                                                                 \
    _Pragma("unroll") for (int k_ = 0; k_ < 4; ++k_) P[(B) + k_] = z_[k_] + s_[k_]; } while (0)
__device__ __forceinline__ void partialSB(f32x16& p0, f32x16& p1, float& R, int kbase, int qrow, bool needmask, int hi) {
  float T0[4], T1[4];
  const int h4 = 4 * hi;
  SBGRP(p1, 12, 32 + 24 + h4, T1[3]); SBGRP(p1, 8, 32 + 16 + h4, T1[2]); SBGRP(p1, 4, 32 + 8 + h4, T1[1]); SBGRP(p1, 0, 32 + h4, T1[0]);
  SBGRP(p0, 12, 24 + h4, T0[3]); SBGRP(p0, 8, 16 + h4, T0[2]); SBGRP(p0, 4, 8 + h4, T0[1]); SBGRP(p0, 0, h4, T0[0]);
  float off0[4], off1[4]; float X = R;
  const float selh = hi ? 0.f : 1.f;
#pragma unroll
  for (int g = 3; g >= 0; --g) { auto rr = __builtin_amdgcn_permlane32_swap(__float_as_uint(T1[g]), __float_as_uint(T1[g]), false, false);
    const float TL = __uint_as_float(rr[0]), TH = __uint_as_float(rr[1]); off1[g] = X + selh * TH; X = X + (TL + TH); }
#pragma unroll
  for (int g = 3; g >= 0; --g) { auto rr = __builtin_amdgcn_permlane32_swap(__float_as_uint(T0[g]), __float_as_uint(T0[g]), false, false);
    const float TL = __uint_as_float(rr[0]), TH = __uint_as_float(rr[1]); off0[g] = X + selh * TH; X = X + (TL + TH); }
  R = X;
#pragma unroll
  for (int r = 0; r < 16; ++r) { p1[r] += off1[r >> 2]; p0[r] += off0[r >> 2]; }
}
__device__ __forceinline__ void finishSB(f32x16& p0, f32x16& p1, bf16x8& pa0, bf16x8& pa1, bf16x8& pa2, bf16x8& pa3) {
#pragma unroll
  for (int r = 0; r < 16; ++r) p0[r] = __builtin_amdgcn_exp2f(p0[r]);
#pragma unroll
  for (int r = 0; r < 16; ++r) p1[r] = __builtin_amdgcn_exp2f(p1[r]);
  PK4(p0, 0, pa0); PK4(p0, 8, pa1); PK4(p1, 0, pa2); PK4(p1, 8, pa3);
}
template <int NQ>
__device__ __forceinline__ void qkt(f32x16& p0, f32x16& p1, const char* Ks, const bf16x8* qr, int r32, int hi, int kcolB) {
  p0 = f32x16{}; p1 = f32x16{};
#pragma unroll
  for (int d0 = 0; d0 < NQ; ++d0) { const int cb = kcolB + (d0 * 16 + hi * 8) * 2;
    bf16x8 b0 = *reinterpret_cast<const bf16x8*>(Ks + KSWZ(r32, cb));
    bf16x8 b1 = *reinterpret_cast<const bf16x8*>(Ks + KSWZ(32 + r32, cb));
    p0 = __builtin_amdgcn_mfma_f32_32x32x16_bf16(b0, qr[d0], p0, 0, 0, 0);
    p1 = __builtin_amdgcn_mfma_f32_32x32x16_bf16(b1, qr[d0], p1, 0, 0, 0); }
}
__device__ __forceinline__ int v_st(int k, int c) { const int kk = (k & ~0xC) | ((k & 4) << 1) | ((k & 8) >> 1); return ((kk >> 3) * 4 + (c >> 5)) * 512 + ((kk & 7) * 32 + (c & 31)) * 2; }
__device__ __forceinline__ int v_rd_base(int lane) { return ((lane & 3) << 3) | (((lane >> 2) & 3) << 6) | (((lane >> 4) & 1) << 5) | (((lane >> 5) & 1) << 8); }
constexpr int v_rd_off(int d0, int ks, int half) { return d0 * 512 + ks * 4096 + half * 2048; }
template <int OFF> __device__ __forceinline__ s16x4 tr_read(int vb) {
  s16x4 r; asm volatile("ds_read_b64_tr_b16 %0, %1 offset:%2" : "=&v"(r) : "v"(vb), "i"(OFF) : "memory"); return r;
}
template <int D0> __device__ __forceinline__ void pv_one(f32x16& od, int vb, bf16x8 pa0, bf16x8 pa1, bf16x8 pa2, bf16x8 pa3) {
  const s16x4 l0 = tr_read<v_rd_off(D0, 0, 0)>(vb), h0 = tr_read<v_rd_off(D0, 0, 1)>(vb), l1 = tr_read<v_rd_off(D0, 1, 0)>(vb), h1 = tr_read<v_rd_off(D0, 1, 1)>(vb);
  const s16x4 l2 = tr_read<v_rd_off(D0, 2, 0)>(vb), h2 = tr_read<v_rd_off(D0, 2, 1)>(vb), l3 = tr_read<v_rd_off(D0, 3, 0)>(vb), h3 = tr_read<v_rd_off(D0, 3, 1)>(vb);
  asm volatile("s_waitcnt lgkmcnt(0)" ::: "memory"); SBAR();
#define PKV(L, H) (bf16x8){L[0], L[1], L[2], L[3], H[0], H[1], H[2], H[3]}
  od = __builtin_amdgcn_mfma_f32_32x32x16_bf16(pa0, PKV(l0, h0), od, 0, 0, 0);
  od = __builtin_amdgcn_mfma_f32_32x32x16_bf16(pa1, PKV(l1, h1), od, 0, 0, 0);
  od = __builtin_amdgcn_mfma_f32_32x32x16_bf16(pa2, PKV(l2, h2), od, 0, 0, 0);
  od = __builtin_amdgcn_mfma_f32_32x32x16_bf16(pa3, PKV(l3, h3), od, 0, 0, 0);
#undef PKV
}
__device__ __forceinline__ void pv_d0(f32x16* o, int vb, bf16x8 pa0, bf16x8 pa1, bf16x8 pa2, bf16x8 pa3) {
  pv_one<0>(o[0], vb, pa0, pa1, pa2, pa3); pv_one<1>(o[1], vb, pa0, pa1, pa2, pa3); pv_one<2>(o[2], vb, pa0, pa1, pa2, pa3); pv_one<3>(o[3], vb, pa0, pa1, pa2, pa3);
}

template <int MODE, typename SRC, int SDEPTH>
__device__ __forceinline__ void attn_pass(const bf16* __restrict__ Qw, const SRC& src, int NT, int nvis, int qrow, int kcolB, f32x16 (&o)[4], float& l_out, char* lds) {
  using St = Stage<typename SRC::T>;
  constexpr int NQ = MODE == 0 ? 4 : 8;
  int tid = threadIdx.x; asm volatile("" : "+v"(tid));
  const int wid = __builtin_amdgcn_readfirstlane(tid >> 6), lane = tid & 63, r32 = lane & 31, hi = lane >> 5;
  char* V_lds = lds; char* K_lds = lds + 2 * SHM_V;
  float* ws = (float*)(lds + 2 * SHM_V + 2 * SHM_K) + wid * 64; float* al_l = ws + 32;
  float m_reg = -1e30f, l_reg = 0.f, Rsb = 0.f; bf16x8 qr[NQ];
#pragma unroll
  for (int d0 = 0; d0 < 4; ++d0) o[d0] = f32x16{};
#pragma unroll
  for (int d0 = 0; d0 < NQ; ++d0) qr[d0] = *reinterpret_cast<const bf16x8*>(Qw + d0 * 16);
  const int sr = tid >> 4, sc = (tid & 15) * 8, vst0 = v_st(sr, sc), vst1 = v_st(32 + sr, sc);
  const int vb0 = (int)(uintptr_t)V_lds + v_rd_base(lane);
  const int qrow0 = qrow - r32;
  struct { typename St::T vs0, vs1, ks0, ks1; } sr_[SDEPTH];
#define TT(s) (MODE == 1 ? (NT - 1 - (s)) : (s))
#define SLOAD(i, s) do { const int ka_ = TT(s) * KVBLK + sr; \
    sr_[i].vs0 = St::ld8(src.vrow(ka_) + sc); sr_[i].vs1 = St::ld8(src.vrow(ka_ + 32) + sc); \
    sr_[i].ks0 = St::ld8(src.krow(ka_) + sc); sr_[i].ks1 = St::ld8(src.krow(ka_ + 32) + sc); } while (0)
#define SWRITE(b, i) do { *(bf16x8*)(V_lds + (b) * SHM_V + vst0) = St::tobf(sr_[i].vs0);          \
    *(bf16x8*)(V_lds + (b) * SHM_V + vst1) = St::tobf(sr_[i].vs1); const int kc = sc * 2;               \
    *(bf16x8*)(K_lds + (b) * SHM_K + KSWZ(sr, kc)) = St::tobf(sr_[i].ks0);                       \
    *(bf16x8*)(K_lds + (b) * SHM_K + KSWZ(32 + sr, kc)) = St::tobf(sr_[i].ks1); } while (0)
#define SWAIT() do { if constexpr (SDEPTH == 2) asm volatile("s_waitcnt vmcnt(4)" ::: "memory"); else asm volatile("s_waitcnt vmcnt(0)" ::: "memory"); } while (0)
#define RESC(a) do { if (MODE == 0) { if (__any((a) < 1.f)) { if (hi == 0) al_l[r32] = (a); asm volatile("s_waitcnt lgkmcnt(0)" ::: "memory"); \
    _Pragma("unroll") for (int d = 0; d < 4; ++d) _Pragma("unroll") for (int r = 0; r < 16; ++r) o[d][r] *= al_l[crow(r, hi)]; } } } while (0)
#define QKT(P0, P1, b, s) do { qkt<NQ>(P0, P1, K_lds + (b) * SHM_K, qr, r32, hi, kcolB); \
    if (MODE == 0) { if (TT(s) >= nvis) { _Pragma("unroll") for (int r = 0; r < 16; ++r) { P0[r] = -1e30f; P1[r] = -1e30f; } } } } while (0)
#define PART(P0, P1, al, s) do { if (MODE == 0) partialSM(P0, P1, m_reg, al); \
    else { const int kb_ = TT(s) * KVBLK; partialSB(P0, P1, Rsb, kb_, qrow, (kb_ + KVBLK > qrow0), hi); } } while (0)
#define FIN(P0, P1, al) do { if (MODE == 0) finishSM(P0, P1, al, l_reg, pa0, pa1, pa2, pa3); else finishSB(P0, P1, pa0, pa1, pa2, pa3); } while (0)
  f32x16 pA0, pA1, pB0, pB1; float alA = 1.f, alB = 1.f; bf16x8 pa0, pa1, pa2, pa3;
  constexpr int SE = 0, SO = SDEPTH - 1;
  SLOAD(SE, 0); asm volatile("s_waitcnt vmcnt(0)" ::: "memory"); SWRITE(0, SE); __syncthreads();
  QKT(pA0, pA1, 0, 0); PART(pA0, pA1, alA, 0);
  SLOAD(SO, 1); if constexpr (SDEPTH == 2) { if (2 < NT) SLOAD(SE, 2); }
  SWAIT(); SWRITE(1, SO); __syncthreads();
  for (int j = 1; j + 1 < NT; j += 2) {
    SBAR(); QKT(pB0, pB1, 1, j);
    FIN(pA0, pA1, alA); SBAR();
    SLOAD(SO, j + SDEPTH); SBAR();
    pv_d0(o, vb0, pa0, pa1, pa2, pa3); PART(pB0, pB1, alB, j);
    __syncthreads(); SWAIT(); SWRITE(0, SE);
    RESC(alB); __syncthreads();
    SBAR(); QKT(pA0, pA1, 0, j + 1);
    FIN(pB0, pB1, alB); SBAR();
    if (SDEPTH == 1 || j + 3 < NT) SLOAD(SE, j + 1 + SDEPTH); SBAR();
    pv_d0(o, vb0 + (int)SHM_V, pa0, pa1, pa2, pa3); PART(pA0, pA1, alA, j + 1);
    __syncthreads(); SWAIT(); SWRITE(1, SO);
    RESC(alA); __syncthreads();
  }
  SBAR(); QKT(pB0, pB1, 1, NT - 1);
  FIN(pA0, pA1, alA); SBAR();
  pv_d0(o, vb0, pa0, pa1, pa2, pa3); PART(pB0, pB1, alB, NT - 1);
  __syncthreads(); RESC(alB);
  FIN(pB0, pB1, alB); SBAR();
  pv_d0(o, vb0 + (int)SHM_V, pa0, pa1, pa2, pa3);
  l_out = l_reg;
  __syncthreads();
#undef TT
#undef SLOAD
#undef SWRITE
#undef SWAIT
#undef RESC
#undef QKT
#undef PART
#undef FIN
}

struct UnitP { int type; int b, h, qb; };
struct Tensors {
  const bf16 *QA, *QB, *KA, *VA, *KB, *VB; bf16 *OA, *OB;
  const float *cKA, *cVA, *cKB, *cVB;
  const float *nKA, *nVA, *nKB, *nVB;
  float* stash;
  const float* subln_g; const float* lamp;
};
constexpr int T_SEQ = 8192, T_PAST = 1024, T_DEC = 64, M_PROMPT = 32768;

__device__ __forceinline__ void store_o_rows(const f32x16 (&o)[4], bf16* Ow, char* lds, int wid, int lane_, bool store) {
  int lane = lane_; asm volatile("" : "+v"(lane));
  const int r32 = lane & 31, hi = lane >> 5;
  bf16* stg = (bf16*)(lds + wid * 8192);
#pragma unroll
  for (int d0 = 0; d0 < 4; ++d0)
#pragma unroll
    for (int r = 0; r < 16; ++r) stg[crow(r, hi) * 128 + d0 * 32 + r32] = (bf16)(cvtpk(o[d0][r], o[d0][r]) & 0xffffu);
  asm volatile("s_waitcnt lgkmcnt(0)" ::: "memory");
  if (store) {
    const int rr = lane >> 4, ch = lane & 15;
#pragma unroll
    for (int i = 0; i < 8; ++i) { const u32x4 v = *(const u32x4*)(stg + (i * 4 + rr) * 128 + ch * 8); *(u32x4*)(Ow + (size_t)(i * 4 + rr) * LD + ch * 8) = v; }
  }
}
template <typename SRC, int SDEPTH>
__device__ __forceinline__ void unit_diff(const UnitP& u, const Tensors& T, const SRC& src, long qrow_g  , int NT, int nvis, bool store, char* lds) {
  int tid = threadIdx.x; asm volatile("" : "+v"(tid));
  const int wid = __builtin_amdgcn_readfirstlane(tid >> 6), lane = tid & 63, r32 = lane & 31, hi = lane >> 5;
  float* wsl = (float*)(lds + 2 * SHM_V + 2 * SHM_K) + wid * 64;
  const bf16* Qrow = T.QA + (size_t)(qrow_g + wid * QBLK + r32) * LD + u.h * 128 + hi * 8;
  f32x4* st = (f32x4*)(T.stash + ((size_t)blockIdx.x * 512 + tid) * 64);
  const float lam = *T.lamp;
#pragma unroll 1
  for (int mp = 0; mp < 2; ++mp) {
    f32x16 o[4]; float l_reg;
    attn_pass<0, SRC, SDEPTH>(Qrow + mp * 64, src, NT, nvis, 0, mp * 128, o, l_reg, lds);
    if (hi == 0) wsl[r32] = l_reg; asm volatile("s_waitcnt lgkmcnt(0)" ::: "memory");
    float rli[16];
#pragma unroll
    for (int r = 0; r < 16; ++r) rli[r] = __builtin_amdgcn_rcpf(wsl[crow(r, hi)]);
    if (mp == 0) {
#pragma unroll
      for (int d0 = 0; d0 < 4; ++d0)
#pragma unroll
        for (int q = 0; q < 4; ++q) st[d0 * 4 + q] = (f32x4){o[d0][4 * q] * rli[4 * q], o[d0][4 * q + 1] * rli[4 * q + 1], o[d0][4 * q + 2] * rli[4 * q + 2], o[d0][4 * q + 3] * rli[4 * q + 3]};
    } else {
      float ss[16];
#pragma unroll
      for (int r = 0; r < 16; ++r) ss[r] = 0.f;
#pragma unroll
      for (int d0 = 0; d0 < 4; ++d0) {
#pragma unroll
        for (int q = 0; q < 4; ++q) { const f32x4 s1 = st[d0 * 4 + q];
#pragma unroll
          for (int k = 0; k < 4; ++k) { const int r = 4 * q + k; const float v = s1[k] - lam * (o[d0][r] * rli[r]); o[d0][r] = v; ss[r] += v * v; } }
        asm volatile("" : "+v"(o[d0]) :: "memory"); }
#pragma unroll
      for (int r = 0; r < 16; ++r) { float s = ss[r]; s += __shfl_xor(s, 1); s += __shfl_xor(s, 2); s += __shfl_xor(s, 4); s += __shfl_xor(s, 8); s += __shfl_xor(s, 16);
        ss[r] = __builtin_amdgcn_rsqf(s * (1.0f / 128.0f) + 1e-6f) * 0.8f; }
#pragma unroll
      for (int d0 = 0; d0 < 4; ++d0) { const float g = T.subln_g[d0 * 32 + r32];
#pragma unroll
        for (int r = 0; r < 16; ++r) o[d0][r] = o[d0][r] * ss[r] * g; }
      store_o_rows(o, T.OA + (size_t)(qrow_g + wid * QBLK) * LD + u.h * 128, lds, wid, lane, store);
    }
    asm volatile("s_waitcnt vmcnt(0) lgkmcnt(0)" ::: "memory"); __syncthreads();
  }
}
template <typename SRC, int SDEPTH>
__device__ __forceinline__ void unit_sb(const UnitP& u, const Tensors& T, const SRC& src, long qrow_g, int qpos0  , int NT, bool store, char* lds) {
  int tid = threadIdx.x; asm volatile("" : "+v"(tid));
  const int wid = __builtin_amdgcn_readfirstlane(tid >> 6), lane = tid & 63, r32 = lane & 31, hi = lane >> 5;
  const bf16* Qrow = T.QB + (size_t)(qrow_g + wid * QBLK + r32) * LD + u.h * 128 + hi * 8;
  f32x16 o[4]; float l_dummy;
  attn_pass<1, SRC, SDEPTH>(Qrow, src, NT, 0, qpos0 + wid * QBLK + r32, 0, o, l_dummy, lds);
  store_o_rows(o, T.OB + (size_t)(qrow_g + wid * QBLK) * LD + u.h * 128, lds, wid, lane, store);
  asm volatile("s_waitcnt vmcnt(0) lgkmcnt(0)" ::: "memory"); __syncthreads();
}
#ifndef ATTMASK
#define ATTMASK 15
#endif
__device__ __forceinline__ void run_unit(const UnitP& u, const Tensors& T, char* lds) {
  const int wid = threadIdx.x >> 6;
  if (u.type < 2) {
    const long row0 = (long)u.b * T_SEQ + u.qb * 256; const size_t kvoff = (size_t)u.b * T_SEQ * LD + u.h * 128;
    const int NT = 4 * u.qb + 4;
#if (ATTMASK >> 0) & 1
    if (u.type == 0) { KVLin s{T.KA + kvoff, T.VA + kvoff};
      unit_diff<KVLin, 2>(u, T, s, row0, NT, 4 * u.qb + (wid >> 1) + 1, true, lds); }
#endif
#if (ATTMASK >> 1) & 1
    if (u.type == 1) { KVLin s{T.KB + kvoff, T.VB + kvoff};
      unit_sb<KVLin, 1>(u, T, s, row0, u.qb * 256, NT, true, lds); }
#endif
  } else {
    const long row0 = (long)M_PROMPT + u.b * T_DEC; const size_t coff = (size_t)u.b * T_PAST * LD + u.h * 128, noff = (size_t)u.b * T_DEC * LD + u.h * 128;
    const int NT = 18; const bool store = wid < 2;
#if (ATTMASK >> 2) & 1
    if (u.type == 2) { KVTwo s{T.cKA + coff, T.cVA + coff, T.nKA + noff, T.nVA + noff, T_PAST};
      unit_diff<KVTwo, 1>(u, T, s, row0, NT, 17, store, lds); }
#endif
#if (ATTMASK >> 3) & 1
    if (u.type == 3) { KVTwo s{T.cKB + coff, T.cVB + coff, T.nKB + noff, T.nVB + noff, T_PAST};
      unit_sb<KVTwo, 1>(u, T, s, row0, T_PAST, NT, store, lds); }
#endif
  }
}
#undef KSWZ
#undef SBAR
#undef PK4
#undef SBGRP
}
constexpr int NWAVES = 8;
constexpr int DM = 2048, DFF = 5504, NPROMPT = 4 * 8192, NSAMPLE = 32 * 64, MTOK = NPROMPT + NSAMPLE;
constexpr int INCOLS = 10240, WQA = 1024;
constexpr float EPS = 1e-6f;
constexpr int N_UNITS = 2560;
constexpr size_t MiB = 1u << 20;
constexpr size_t WS_CTL = 0, CTL_ZERO_BYTES = 1 * MiB;
constexpr size_t WS_ROPE = 1 * MiB;
constexpr size_t WS_LIST = 1 * MiB + 512 * 1024;
constexpr size_t WS_LAM = WS_LIST + 16 * 1024;
constexpr size_t WS_WIN = 2 * MiB;
constexpr size_t WS_F1GU = WS_WIN + (size_t)INCOLS * DM * 2;
constexpr size_t WS_F1D = WS_F1GU + (size_t)2 * DFF * DM * 2;
constexpr size_t WS_F2GU = WS_F1D + (size_t)DM * DFF * 2;
constexpr size_t WS_F2D = WS_F2GU + (size_t)2 * DFF * DM * 2;
constexpr size_t WS_WAB = WS_F2D + (size_t)DM * DFF * 2;
constexpr size_t WS_WO = WS_WAB + (size_t)4096 * 1024 * 2;
constexpr size_t WS_XN = WS_WO + (size_t)DM * DM * 2;
constexpr size_t WS_D = WS_XN + (size_t)MTOK * DM * 2;
constexpr size_t WS_BIG = WS_D + (size_t)MTOK * DM * 2;
constexpr size_t SZ_HEAD = (size_t)MTOK * 1024 * 2;
constexpr size_t WS_QA = WS_BIG, WS_QB = WS_QA + SZ_HEAD, WS_KA = WS_QB + SZ_HEAD, WS_VA = WS_KA + SZ_HEAD, WS_KB = WS_VA + SZ_HEAD, WS_VB = WS_KB + SZ_HEAD;
constexpr size_t WS_SGA = WS_VB + SZ_HEAD, WS_SGB = WS_SGA + 2 * SZ_HEAD, WS_END = WS_SGB + 2 * SZ_HEAD;
static_assert(WS_BIG + (size_t)MTOK * DFF * 2 <= WS_END, "ACT fits the big region");
static_assert((size_t)256 * 64 * 512 * 4 <= (size_t)MTOK * DM * 2, "stash fits the D region");
constexpr int CW_TMO = 0, CW_QUEUE = 64, CW_BAR = 4096;

constexpr int RING_OFF = 0, RING_BYTES = 131072;
constexpr int LDSCTL_OFF = RING_BYTES, MISC_OFF = LDSCTL_OFF + 320;
constexpr int LDS_BYTES = 147456;
static_assert(MISC_OFF + 128 <= LDS_BYTES, "LDS map");
static_assert(att::SHM_ATTN <= RING_BYTES, "attention scratch fits the ring");

#define GAS __attribute__((address_space(1)))
#define LAS __attribute__((address_space(3)))
typedef unsigned short bf16;
typedef unsigned v4u __attribute__((ext_vector_type(4)));
typedef float f32x4 __attribute__((ext_vector_type(4)));
typedef short bf16x8 __attribute__((ext_vector_type(8)));
typedef GAS unsigned gu32;
typedef GAS unsigned long long gu64;
#define RLX_AGENT __ATOMIC_RELAXED, __HIP_MEMORY_SCOPE_AGENT
#define LDS_WAIT() asm volatile("s_waitcnt lgkmcnt(0)" ::: "memory")
#define VM_WAIT() asm volatile("s_waitcnt vmcnt(0)" ::: "memory")
__device__ __forceinline__ unsigned long long rt() { return __builtin_amdgcn_s_memrealtime(); }
__device__ __forceinline__ unsigned f2bf(float f) { unsigned u = __builtin_bit_cast(unsigned, f); return (u + 0x7fffu + ((u >> 16) & 1u)) >> 16; }
__device__ __forceinline__ unsigned pk2(float lo, float hi) { return f2bf(lo) | (f2bf(hi) << 16); }

#define XB_TMO      128
#define XB_XCNT(j)  (256  + 64 * (j))
#define XB_XSUB(j)  (1280 + 64 * (j))
#define XB_XGEN(j)  (2304 + 64 * (j))
#define XB_TOP      3328
#define XB_TOPGEN   3392
#define XCD_BAR_WORDS 3456
#define XB_SPIN_CAP (1u << 18)

__device__ __forceinline__ unsigned xb_ld(unsigned* p)              { return __hip_atomic_load(p, __ATOMIC_RELAXED, __HIP_MEMORY_SCOPE_AGENT); }
__device__ __forceinline__ unsigned xb_add(unsigned* p, unsigned v) { return __hip_atomic_fetch_add(p, v, __ATOMIC_RELAXED, __HIP_MEMORY_SCOPE_AGENT); }
__device__ __forceinline__ unsigned xb_xcc_id() { return (unsigned)__builtin_amdgcn_s_getreg((3 << 11) | 20) & 0xFu; }
#define XB_SPIN(cond, bar) do { unsigned _sp = 0; while (cond) { __builtin_amdgcn_s_sleep(1); \
    if ((++_sp & 255u) == 0u) { if (xb_ld(&(bar)[XB_TMO])) break; if (_sp > XB_SPIN_CAP) { atomicAdd(&(bar)[XB_TMO], 1u); break; } } } } while (0)

struct XcdBarrier {
    unsigned* bar; unsigned x;
    volatile LAS unsigned* st;
};

__device__ __forceinline__ XcdBarrier xcd_barrier_post(unsigned* bar, volatile LAS unsigned* st) {
    XcdBarrier b; b.bar = bar; b.x = xb_xcc_id(); b.st = st;
    if (threadIdx.x == 0) (void)xb_add(&bar[XB_XCNT(b.x)], 1u);
    return b;
}
__device__ __forceinline__ void xcd_barrier_complete(unsigned* bar, unsigned x, unsigned& nloc, unsigned& nx) {
    const unsigned G = gridDim.x * gridDim.y * gridDim.z;
    unsigned sum, cnt, mine, sp = 0u;
    for (;;) {
        sum = 0u; cnt = 0u; mine = 0u;
#pragma unroll
        for (unsigned j = 0; j < 16; ++j) { const unsigned c = xb_ld(&bar[XB_XCNT(j)]); sum += c; cnt += (c > 0u) ? 1u : 0u; mine = (j == x) ? c : mine; }
        if (sum == G) break;
        __builtin_amdgcn_s_sleep(1);
        if ((++sp & 255u) == 0u) { if (xb_ld(&bar[XB_TMO])) break; if (sp > XB_SPIN_CAP) { atomicAdd(&bar[XB_TMO], 1u); break; } }
    }
    nloc = mine > 0u ? mine : 1u; nx = cnt > 0u ? cnt : 1u;
}

__device__ __forceinline__ void xcd_barrier(const XcdBarrier& b) {
    asm volatile("s_waitcnt vmcnt(0)" ::: "memory");
    __syncthreads();
    if (threadIdx.x == 0) {
        unsigned* bar = b.bar;
        __builtin_amdgcn_s_waitcnt(0);
        unsigned nloc = b.st[0], nx = b.st[1];
        if (nloc == 0u) { xcd_barrier_complete(bar, b.x, nloc, nx); b.st[0] = nloc; b.st[1] = nx; }
        const unsigned old = xb_add(&bar[XB_XSUB(b.x)], 1u);
        const unsigned gen = old / nloc;
        if (old + 1u == (gen + 1u) * nloc) {
            __builtin_amdgcn_fence(__ATOMIC_RELEASE, "agent");
            asm volatile("s_waitcnt vmcnt(0)" ::: "memory");
            const unsigned og = xb_add(&bar[XB_TOP], 1u);
            const unsigned tg = og / nx;
            if (og + 1u == (tg + 1u) * nx) xb_add(&bar[XB_TOPGEN], 1u);
            else XB_SPIN(xb_ld(&bar[XB_TOPGEN]) == tg, bar);
            __builtin_amdgcn_fence(__ATOMIC_ACQUIRE, "agent");
            xb_add(&bar[XB_XGEN(b.x)], 1u);
            asm volatile("s_waitcnt vmcnt(0)" ::: "memory");
        } else {
            XB_SPIN(xb_ld(&bar[XB_XGEN(b.x)]) == gen, bar);
            __builtin_amdgcn_fence(__ATOMIC_ACQUIRE, "agent");
            asm volatile("s_waitcnt vmcnt(0)" ::: "memory");
        }
    }
    __syncthreads();
}

struct Inputs {
    const float *x_prompt, *x_sample, *cdk, *cdv, *csk, *csv, *w_in, *w_up_a, *w_up_b, *w_o, *lq1, *lk1, *lq2, *lk2, *subln_g;
    const float *n1a, *n1b, *nma, *nmb, *n2a, *n2b, *f1g, *f1u, *f1d, *f2g, *f2u, *f2d;
};
struct Args { Inputs in; float* out; unsigned char* ws; };

__constant__ float ROPE_INVF[8] = {1.0f, 0.1939227432012558f, 0.03760603070259094f, 0.007292664609849453f, 0.0014142135623842478f, 0.00027424818836152554f, 5.318296098266728e-05f, 1.0313386155758053e-05f};

__device__ __forceinline__ float wave_sum(float v) {
#pragma unroll
    for (int o = 1; o < 64; o <<= 1) v += __shfl_xor(v, o);
    return v;
}
__device__ __forceinline__ void transpose_item(const float* W, int K, int N, bf16* WT, int k0, int n0, int drow0, LAS float* scr, int lane) {
#pragma unroll 8
    for (int i = 0; i < 32; ++i) { const int kk = 2 * i + (lane >> 5); scr[kk * 33 + (lane & 31)] = W[(size_t)(k0 + kk) * N + n0 + (lane & 31)]; }
    LDS_WAIT(); asm volatile("" ::: "memory");
    const int c = lane & 7;
#pragma unroll
    for (int j = 0; j < 4; ++j) { const int n = (lane >> 3) + 8 * j; const LAS float* s = scr + (8 * c) * 33 + n;
        v4u o; o.x = pk2(s[0 * 33], s[1 * 33]); o.y = pk2(s[2 * 33], s[3 * 33]); o.z = pk2(s[4 * 33], s[5 * 33]); o.w = pk2(s[6 * 33], s[7 * 33]);
        *(GAS v4u*)(WT + (size_t)(drow0 + n) * K + k0 + 8 * c) = o; }
    LDS_WAIT(); asm volatile("" ::: "memory");
}
__device__ __forceinline__ void transpose_matrix_item(const float* W, int K, int N, bf16* WT, int row_off, int gu, int item, LAS float* scr, int lane) {
    const int nblk = N / 32, kb = item / nblk, nb = item % nblk, k0 = 64 * kb, n0 = 32 * nb;
    const int drow0 = gu == 0 ? row_off + n0 : 256 * (n0 >> 7) + (n0 & 127) + (gu == 2 ? 128 : 0);
    transpose_item(W, K, N, WT, k0, n0, drow0, scr, lane);
}
template <bool HAS_D>
__device__ __forceinline__ void thin_row(const float* res, const bf16* d, float coef, const float* gpost, float* out_res, const float* gpre, bf16* xn, int lane, float oscale = 1.f) {
    const GAS f32x4* xr = (const GAS f32x4*)res + lane;
    f32x4 v[8];
#pragma unroll
    for (int j = 0; j < 8; ++j) v[j] = xr[64 * j];
    if (HAS_D) {
        const GAS unsigned long long* dr = (const GAS unsigned long long*)d + lane;
        f32x4 dv[8]; float s = 0.f;
#pragma unroll
        for (int j = 0; j < 8; ++j) { const unsigned long long w = dr[64 * j]; const unsigned lo = (unsigned)w, hi = (unsigned)(w >> 32);
            dv[j] = (f32x4){__uint_as_float(lo << 16), __uint_as_float(lo & 0xffff0000u), __uint_as_float(hi << 16), __uint_as_float(hi & 0xffff0000u)};
            s += (dv[j].x * dv[j].x + dv[j].y * dv[j].y) + (dv[j].z * dv[j].z + dv[j].w * dv[j].w); }
        const float rstd = coef / sqrtf(wave_sum(s) * (1.f / DM) + EPS);
        const GAS f32x4* gp = (const GAS f32x4*)gpost + lane;
#pragma unroll
        for (int j = 0; j < 8; ++j) { const f32x4 g = gp[64 * j]; v[j] = v[j] + dv[j] * g * rstd; }
    }
    if (out_res) { GAS f32x4* orow = (GAS f32x4*)out_res + lane;
#pragma unroll
        for (int j = 0; j < 8; ++j) orow[64 * j] = v[j] * oscale; }
    if (xn) {
        float s2 = 0.f;
#pragma unroll
        for (int j = 0; j < 8; ++j) s2 += (v[j].x * v[j].x + v[j].y * v[j].y) + (v[j].z * v[j].z + v[j].w * v[j].w);
        const float rstd = 1.f / sqrtf(wave_sum(s2) * (1.f / DM) + EPS);
        const GAS f32x4* gp = (const GAS f32x4*)gpre + lane;
        GAS unsigned long long* o8 = (GAS unsigned long long*)xn + lane;
#pragma unroll
        for (int j = 0; j < 8; ++j) { const f32x4 g = gp[64 * j];
            o8[64 * j] = (unsigned long long)pk2(v[j].x * rstd * g.x, v[j].y * rstd * g.y) | ((unsigned long long)pk2(v[j].z * rstd * g.z, v[j].w * rstd * g.w) << 32); }
    }
}
__device__ __forceinline__ void rope_entry(int pos, int i, float& c, float& s) {
    const float angf = (float)pos * ROPE_INVF[i];
    const double a = (double)angf;
    const double k = __builtin_rint(a * 0.15915494309189535);
    double r = __builtin_fma(-k, 6.283185307179586, a); r = __builtin_fma(-k, 2.4492935982947064e-16, r);
    const double q = __builtin_rint(r * 0.6366197723675814);
    double y = __builtin_fma(-q, 1.5707963267948966, r); y = __builtin_fma(-q, 6.123233995736766e-17, y);
    const double y2 = y * y;
    const double sy = y * (1.0 + y2 * (-1.0 / 6.0 + y2 * (1.0 / 120.0 + y2 * (-1.0 / 5040.0 + y2 * (1.0 / 362880.0 + y2 * (-1.0 / 39916800.0 + y2 * (1.0 / 6227020800.0)))))));
    const double cy = 1.0 + y2 * (-0.5 + y2 * (1.0 / 24.0 + y2 * (-1.0 / 720.0 + y2 * (1.0 / 40320.0 + y2 * (-1.0 / 3628800.0 + y2 * (1.0 / 479001600.0 + y2 * (-1.0 / 87178291200.0)))))));
    const int qi = ((int)q) & 3;
    const double sv = qi == 0 ? sy : qi == 1 ? cy : qi == 2 ? -sy : -cy;
    const double cv = qi == 0 ? cy : qi == 1 ? -sy : qi == 2 ? -cy : sy;
    c = (float)cv; s = (float)sv;
}
__device__ __forceinline__ void unit_decode(int u, att::UnitP& p) {
    if (u < 1024) { p.type = 0; p.b = u >> 8; p.h = (u >> 5) & 7; p.qb = u & 31; }
    else if (u < 2048) { const int v = u - 1024; p.type = 1; p.b = v >> 8; p.h = (v >> 5) & 7; p.qb = v & 31; }
    else if (u < 2304) { const int v = u - 2048; p.type = 2; p.b = v >> 3; p.h = v & 7; p.qb = 0; }
    else { const int v = u - 2304; p.type = 3; p.b = v >> 3; p.h = v & 7; p.qb = 0; }
}
__device__ __forceinline__ int unit_cost(int u) {
    if (u < 1024) return 80 * ((u & 31) + 1);
    if (u < 2048) return 64 * ((u & 31) + 1);
    if (u < 2304) return 432;
    return 324;
}


__device__ __forceinline__ float bf_round(float v) { return __uint_as_float(att::cvtpk(v, v) << 16); }
__device__ __forceinline__ void sample_diff_rowhead(int r  , int head, const bf16* QA, bf16* OA, const float* cdk, const float* cdv, const float* nk, const float* nv, const float* subg, float lam, int lane) {
    const int b = r >> 6; const size_t qoff = (size_t)(NPROMPT + r) * 1024 + head * 128 + 2 * lane;
    const unsigned qw = *(const unsigned*)(QA + qoff); const float q0 = __uint_as_float(qw << 16), q1 = __uint_as_float(qw & 0xffff0000u);
    const float* kc = cdk + (size_t)b * 1024 * 1024 + head * 128 + 2 * lane; const float* vc = cdv + (size_t)b * 1024 * 1024 + head * 128 + 2 * lane;
    const float* kn = nk + (size_t)b * 64 * 1024 + head * 128 + 2 * lane; const float* vn = nv + (size_t)b * 64 * 1024 + head * 128 + 2 * lane;
    const bool lo = lane < 32;
    float m0 = -1e30f, m1 = -1e30f, l0 = 0.f, l1 = 0.f, a00 = 0.f, a01 = 0.f, a10 = 0.f, a11 = 0.f;
    for (int kp = 0; kp < 1088; ++kp) {
        const float* kr = kp < 1024 ? kc + (size_t)kp * 1024 : kn + (size_t)(kp - 1024) * 1024; const float* vr = kp < 1024 ? vc + (size_t)kp * 1024 : vn + (size_t)(kp - 1024) * 1024;
        const float2 kk = *(const float2*)kr, vv = *(const float2*)vr;
        const float part = q0 * bf_round(kk.x) + q1 * bf_round(kk.y);
        float s0 = lo ? part : 0.f, s1 = lo ? 0.f : part;
#pragma unroll
        for (int o = 1; o < 64; o <<= 1) { s0 += __shfl_xor(s0, o); s1 += __shfl_xor(s1, o); }
        const float v0 = bf_round(vv.x), v1 = bf_round(vv.y);
        { const float mn = fmaxf(m0, s0), al = __builtin_amdgcn_exp2f(m0 - mn), p = __builtin_amdgcn_exp2f(s0 - mn); l0 = l0 * al + p; a00 = a00 * al + p * v0; a01 = a01 * al + p * v1; m0 = mn; }
        { const float mn = fmaxf(m1, s1), al = __builtin_amdgcn_exp2f(m1 - mn), p = __builtin_amdgcn_exp2f(s1 - mn); l1 = l1 * al + p; a10 = a10 * al + p * v0; a11 = a11 * al + p * v1; m1 = mn; }
    }
    const float o0 = a00 / l0 - lam * (a10 / l1), o1 = a01 / l0 - lam * (a11 / l1);
    const float rs = 0.8f * __builtin_amdgcn_rsqf(wave_sum(o0 * o0 + o1 * o1) * (1.f / 128.f) + 1e-6f);
    *(unsigned*)(OA + qoff) = pk2(o0 * rs * subg[2 * lane], o1 * rs * subg[2 * lane + 1]);
}

#ifdef DEBUG_CHECK
constexpr int CW_ERR = 128;
__device__ __forceinline__ float bf2f(bf16 b) { return __uint_as_float((unsigned)b << 16); }
__device__ __forceinline__ void chk_record(gu32* ctl, int k, float got, float want, float tol_abs, float tol_rel, int lane) {
    float e = __builtin_fabsf(got - want) / (tol_abs + tol_rel * __builtin_fabsf(want));
    if (!(e == e)) e = 1e6f;
#pragma unroll
    for (int o = 1; o < 64; o <<= 1) e = fmaxf(e, __shfl_xor(e, o));
    if (lane == 0) atomicMax((unsigned*)(ctl + CW_ERR + 64 * k), __float_as_uint(e));
}
__device__ __forceinline__ unsigned hash_u(unsigned x) { x ^= x >> 16; x *= 0x7feb352dU; x ^= x >> 15; x *= 0x846ca68bU; x ^= x >> 16; return x; }
__device__ __forceinline__ float dot_bf_col(const bf16* arow, const float* W, int K, int N, int c, int lane) {
    float s = 0.f; for (int k = lane; k < K; k += 64) s += bf2f(arow[k]) * W[(size_t)k * N + c];
    return wave_sum(s);
}
#define NCHK 96
__device__ __forceinline__ void chk_ffn_gu(gu32* ctl, int k, const bf16* XN, const float* wg, const float* wu, const bf16* ACT, int gw, int NGW, int lane) {
    for (int i = gw; i < NCHK; i += NGW) { const unsigned h = hash_u(i * 7919u + k); const int r = (i & 3) == 3 ? NPROMPT + (int)(h % NSAMPLE) : (int)(h % NPROMPT); const int c = (int)((h >> 8) % DFF);
        const float g = dot_bf_col(XN + (size_t)r * DM, wg, DM, DFF, c, lane), u = dot_bf_col(XN + (size_t)r * DM, wu, DM, DFF, c, lane);
        const float want = g / (1.f + __expf(-g)) * u;
        chk_record(ctl, k, bf2f(ACT[(size_t)r * DFF + c]), want, 0.02f, 0.02f, lane); }
}
__device__ __forceinline__ void chk_gemm(gu32* ctl, int k, const bf16* A, int K, const float* W, int N, const bf16* OUT, int gw, int NGW, int lane) {
    for (int i = gw; i < NCHK; i += NGW) { const unsigned h = hash_u(i * 7919u + k); const int r = (i & 3) == 3 ? NPROMPT + (int)(h % NSAMPLE) : (int)(h % NPROMPT); const int c = (int)((h >> 8) % N);
        const float want = dot_bf_col(A + (size_t)r * K, W, K, N, c, lane);
        chk_record(ctl, k, bf2f(OUT[(size_t)r * N + c]), want, 0.02f, 0.02f, lane); }
}
__device__ __forceinline__ void chk_thin(gu32* ctl, int k, const float* resp, const float* ress, const bf16* D, float coef, const float* gpost, const float* out_res, const float* gpre, const bf16* XN, int gw, int NGW, int lane) {
    for (int i = gw; i < NCHK; i += NGW) { const unsigned h = hash_u(i * 7919u + k); const int r = (i & 3) == 3 ? NPROMPT + (int)(h % NSAMPLE) : (int)(h % NPROMPT);
        if (!resp) { float st = 0.f; for (int c = lane; c < DM; c += 64) { const float t = out_res[(size_t)r * DM + c]; st += t * t; }
            const float rt = 1.f / sqrtf(wave_sum(st) / DM + EPS); const int c = (int)((h >> 8) % DM);
            chk_record(ctl, k, bf2f(XN[(size_t)r * DM + c]), out_res[(size_t)r * DM + c] * rt * gpre[c], 0.02f, 0.02f, lane); continue; }
        const float* res = (r < NPROMPT || !ress) ? resp + (size_t)r * DM : ress + (size_t)(r - NPROMPT) * DM;
        float sd = 0.f; for (int c = lane; c < DM; c += 64) { const float d = bf2f(D[(size_t)r * DM + c]); sd += d * d; }
        const float rs = coef / sqrtf(wave_sum(sd) / DM + EPS);
        float st = 0.f; for (int c = lane; c < DM; c += 64) { const float t = res[c] + bf2f(D[(size_t)r * DM + c]) * rs * gpost[c]; st += t * t; }
        const float rt = 1.f / sqrtf(wave_sum(st) / DM + EPS);
        const int c = (int)((h >> 8) % DM); const float t = res[c] + bf2f(D[(size_t)r * DM + c]) * rs * gpost[c];
        if (out_res != resp) chk_record(ctl, k, out_res[(size_t)r * DM + c], t, 0.01f, 0.01f, lane);
        if (XN) chk_record(ctl, k, bf2f(XN[(size_t)r * DM + c]), t * rt * gpre[c], 0.02f, 0.02f, lane); }
}
__device__ __forceinline__ void chk_win(gu32* ctl, const bf16* XN, const float* w_in, unsigned char* ws, const float* outp, int gw, int NGW, int lane) {
    for (int i = gw; i < 2 * NCHK; i += NGW) { const unsigned h = hash_u(i * 7919u + 4); const int r = (i & 3) == 3 ? NPROMPT + (int)(h % NSAMPLE) : (int)(h % NPROMPT); int c = (int)((h >> 8) % INCOLS);
        if ((i & 7) < 3) c = ((c / 64) * 64 + (c & 15)) % 2048;
        float v = dot_bf_col(XN + (size_t)r * DM, w_in, DM, INCOLS, c, lane);
        const int seg = c < 6144 ? c >> 10 : (c < 8192 ? 6 : 7); const int cl = c < 6144 ? c & 1023 : (c - 6144) & 2047;
        if (seg <= 1 && (cl & 63) < 16) { const int j = cl & 7; const bool first = (cl & 15) < 8; const int cp = first ? c + 8 : c - 8;
            const float vp = dot_bf_col(XN + (size_t)r * DM, w_in, DM, INCOLS, cp, lane);
            const int pos = r < NPROMPT ? (r & 8191) : 1024 + (r & 63);
            const float cs = ((const float*)(ws + WS_ROPE))[pos * 16 + j], sn = ((const float*)(ws + WS_ROPE))[pos * 16 + 8 + j];
            v = first ? v * cs - vp * sn : v * cs + vp * sn; }
        if (seg < 6) { const float sc = seg == 0 ? 0.18033688011112042f : seg == 3 ? 0.12751743082459868f : 1.f;
            const size_t ho = seg == 0 ? WS_QA : seg == 1 ? WS_KA : seg == 2 ? WS_VA : seg == 3 ? WS_QB : seg == 4 ? WS_KB : WS_VB;
            chk_record(ctl, 4, bf2f(((const bf16*)(ws + ho))[(size_t)r * 1024 + cl]), v * sc, 0.02f, 0.02f, lane);
            if (seg != 0 && seg != 3) { const int oi = seg == 1 ? 0 : seg == 2 ? 1 : seg == 4 ? 2 : 3;
                const float* fo = r < NPROMPT ? outp + (size_t)MTOK * DM + (size_t)oi * NPROMPT * 1024 + (size_t)r * 1024 : outp + (size_t)MTOK * DM + 4 * (size_t)NPROMPT * 1024 + (size_t)oi * NSAMPLE * 1024 + (size_t)(r - NPROMPT) * 1024;
                chk_record(ctl, 4, fo[cl], v, 0.01f, 0.01f, lane); } }
        else chk_record(ctl, 4, bf2f(((const bf16*)(ws + (seg == 6 ? WS_SGA : WS_SGB)))[(size_t)r * 2048 + cl]), 1.f / (1.f + __expf(-v)), 0.01f, 0.01f, lane); }
}
__device__ __forceinline__ float kv_at(bool sample, const bf16* Bb, const float* cache, const float* newr, int b, int kpos, int col) {
    if (!sample) return bf2f(Bb[((size_t)b * 8192 + kpos) * 1024 + col]);
    const float v = kpos < 1024 ? cache[((size_t)b * 1024 + kpos) * 1024 + col] : newr[((size_t)b * 64 + (kpos - 1024)) * 1024 + col];
    return bf2f((bf16)(att::cvtpk(v, v) & 0xffffu));
}
__device__ __forceinline__ void chk_attn(gu32* ctl, unsigned char* ws, const float* cdk, const float* cdv, const float* subg, const float* outp, const bf16* QAsave, int gw, int NGW, int lane) {
    const bf16* QA = (const bf16*)(ws + WS_QA); const bf16* KA = (const bf16*)(ws + WS_KA); const bf16* VA = (const bf16*)(ws + WS_VA);
    const float* nk = outp + (size_t)MTOK * DM + 4 * (size_t)NPROMPT * 1024;
    const float lam = *(const float*)(ws + WS_LAM);
    for (int i = gw; i < NCHK; i += NGW) { const unsigned hh = hash_u(i * 7919u + 5); const bool sample = (i & 3) == 3;
        int r = sample ? NPROMPT + (int)(hh % NSAMPLE) : (int)(hh % NPROMPT);
        if ((i & 7) == 0) r = (r & ~8191) + (int)((hh >> 20) % 200);
        if ((i & 7) == 4) r = (r & ~63) + (int)((hh >> 20) % 4);
        const int head = (int)((hh >> 12) & 7), b = sample ? (r - NPROMPT) / 64 : r / 8192, qpos = sample ? 1024 + (r & 63) : (r & 8191);
        const int c0 = head * 128 + 2 * lane;
        {
            const int nk_vis = sample ? 1088 : ((qpos >> 6) + 1) * 64;
            float Om[2][2];
            for (int m = 0; m < 2; ++m) {
                const bool mine = (lane >> 5) == m; const int qc = head * 128 + 2 * lane;
                const float q0 = bf2f(QAsave[(size_t)i * 128 + 2 * lane]), q1 = bf2f(QAsave[(size_t)i * 128 + 2 * lane + 1]);
                float mx = -1e30f, l = 0.f, a0 = 0.f, a1 = 0.f;
                for (int kp = 0; kp < nk_vis; ++kp) {
                    const float k0 = kv_at(sample, KA, cdk, nk, b, kp, qc), k1 = kv_at(sample, KA, cdk, nk, b, kp, qc + 1);
                    const float s = wave_sum(mine ? q0 * k0 + q1 * k1 : 0.f);
                    const float v0 = kv_at(sample, VA, cdv, nk + (size_t)NSAMPLE * 1024, b, kp, c0), v1 = kv_at(sample, VA, cdv, nk + (size_t)NSAMPLE * 1024, b, kp, c0 + 1);
                    const float mn = fmaxf(mx, s), al = exp2f(mx - mn), p = exp2f(s - mn);
                    l = l * al + p; a0 = a0 * al + p * v0; a1 = a1 * al + p * v1; mx = mn; }
                Om[m][0] = a0 / l; Om[m][1] = a1 / l; }
            const float o0 = Om[0][0] - lam * Om[1][0], o1 = Om[0][1] - lam * Om[1][1];
            const float rs = 0.8f / sqrtf(wave_sum(o0 * o0 + o1 * o1) / 128.f + 1e-6f);
            const int kk = sample ? 12 : (i & 7) == 0 ? 13 : (i & 7) == 4 ? 14 : 5;
            chk_record(ctl, kk, bf2f(QA[(size_t)r * 1024 + c0]), o0 * rs * subg[2 * lane], 0.03f, 0.03f, lane);
            chk_record(ctl, kk, bf2f(QA[(size_t)r * 1024 + c0 + 1]), o1 * rs * subg[2 * lane + 1], 0.03f, 0.03f, lane);
        }
    }
}
__device__ __forceinline__ void chk_attn_sb(gu32* ctl, unsigned char* ws, const float* csk, const float* csv, const float* outp, const bf16* QBsave, int gw, int NGW, int lane) {
    const bf16* OB = (const bf16*)(ws + WS_QB); const bf16* KB = (const bf16*)(ws + WS_KB); const bf16* VB = (const bf16*)(ws + WS_VB);
    const float* nk = outp + (size_t)MTOK * DM + 4 * (size_t)NPROMPT * 1024 + 2 * (size_t)NSAMPLE * 1024;
    for (int i = gw; i < NCHK; i += NGW) { const unsigned hh = hash_u(i * 7919u + 6); const bool sample = (i & 3) == 3;
        int r = sample ? NPROMPT + (int)(hh % NSAMPLE) : (int)(hh % NPROMPT);
        if ((i & 7) == 0) r = (r & ~8191) + (int)((hh >> 20) % 200);
        if ((i & 7) == 4) r = (r & ~63) + (int)((hh >> 20) % 4);
        const int head = (int)((hh >> 12) & 7), b = sample ? (r - NPROMPT) / 64 : r / 8192, qpos = sample ? 1024 + (r & 63) : (r & 8191);
        const int c0 = head * 128 + 2 * lane;
        const float q0 = bf2f(QBsave[(size_t)i * 128 + 2 * lane]), q1 = bf2f(QBsave[(size_t)i * 128 + 2 * lane + 1]);
        float cum = 0.f, a0 = 0.f, a1 = 0.f;
        for (int kp = qpos - 1; kp >= 0 && cum > -200.f; --kp) {
            const float k0 = kv_at(sample, KB, csk, nk, b, kp, c0), k1 = kv_at(sample, KB, csk, nk, b, kp, c0 + 1);
            const float z = wave_sum(q0 * k0 + q1 * k1);
            const float sp = fmaxf(z, 0.f) + log2f(1.f + exp2f(-__builtin_fabsf(z)));
            const float A = exp2f(z - sp + cum); cum -= sp;
            const float v0 = kv_at(sample, VB, csv, nk + (size_t)NSAMPLE * 1024, b, kp, c0), v1 = kv_at(sample, VB, csv, nk + (size_t)NSAMPLE * 1024, b, kp, c0 + 1);
            a0 += A * v0; a1 += A * v1; }
        chk_record(ctl, 6, bf2f(OB[(size_t)r * 1024 + c0]), a0, 0.03f, 0.03f, lane);
        chk_record(ctl, 6, bf2f(OB[(size_t)r * 1024 + c0 + 1]), a1, 0.03f, 0.03f, lane);
    }
}
__device__ __forceinline__ void chk_save_q(unsigned char* ws, bf16* QAsave, bf16* QBsave, int gw, int NGW, int lane) {
    const bf16* QA = (const bf16*)(ws + WS_QA); const bf16* QB = (const bf16*)(ws + WS_QB);
    for (int i = gw; i < NCHK; i += NGW) {
        for (int t = 0; t < 2; ++t) { const unsigned hh = hash_u(i * 7919u + 5 + t); const bool sample = (i & 3) == 3;
            int r = sample ? NPROMPT + (int)(hh % NSAMPLE) : (int)(hh % NPROMPT);
            if ((i & 7) == 0) r = (r & ~8191) + (int)((hh >> 20) % 200);
            if ((i & 7) == 4) r = (r & ~63) + (int)((hh >> 20) % 4);
            const int head = (int)((hh >> 12) & 7);
            bf16* dst = (t == 0 ? QAsave : QBsave) + (size_t)i * 128; const bf16* src = (t == 0 ? QA : QB) + (size_t)r * 1024 + head * 128;
            dst[2 * lane] = src[2 * lane]; dst[2 * lane + 1] = src[2 * lane + 1]; } }
}
__device__ __forceinline__ void chk_merge(gu32* ctl, unsigned char* ws, const float* wa, const float* wb, int gw, int NGW, int lane) {
    const bf16* OA = (const bf16*)(ws + WS_QA); const bf16* OB = (const bf16*)(ws + WS_QB); const bf16* SGA = (const bf16*)(ws + WS_SGA); const bf16* SGB = (const bf16*)(ws + WS_SGB); const bf16* MG = (const bf16*)(ws + WS_XN);
    for (int i = gw; i < NCHK; i += NGW) { const unsigned h = hash_u(i * 7919u + 7); const int r = (i & 3) == 3 ? NPROMPT + (int)(h % NSAMPLE) : (int)(h % NPROMPT); const int c = (int)((h >> 8) % DM);
        const float pa = dot_bf_col(OA + (size_t)r * 1024, wa, 1024, DM, c, lane), pb = dot_bf_col(OB + (size_t)r * 1024, wb, 1024, DM, c, lane);
        const float want = bf2f(SGA[(size_t)r * DM + c]) * pa + bf2f(SGB[(size_t)r * DM + c]) * pb;
        chk_record(ctl, 7, bf2f(MG[(size_t)r * DM + c]), want, 0.02f, 0.02f, lane); }
}

#ifdef DEBUG_VAR
__device__ __forceinline__ void chk_attn_var(gu32* ctl, unsigned char* ws, const float* cdk, const float* cdv, const float* subg, const float* outp, const bf16* QAsave, int gw, int NGW, int lane) {
    const bf16* QA = (const bf16*)(ws + WS_QA); const bf16* KA = (const bf16*)(ws + WS_KA); const bf16* VA = (const bf16*)(ws + WS_VA);
    const float* nk = outp + (size_t)MTOK * DM + 4 * (size_t)NPROMPT * 1024;
    const float lam = *(const float*)(ws + WS_LAM);
    for (int i = gw; i < NCHK; i += NGW) { const unsigned hh = hash_u(i * 7919u + 5); const bool sample = (i & 3) == 3; if (!sample) continue;
        const int r = NPROMPT + (int)(hh % NSAMPLE);
        const int head = (int)((hh >> 12) & 7), b = (r - NPROMPT) / 64;
        const int c0 = head * 128 + 2 * lane;
        for (int v = 0; v < 35; ++v) {
            float Om[2][2];
            for (int m = 0; m < 2; ++m) {
                const bool mine = (lane >> 5) == m; const int qc = head * 128 + 2 * lane;
                const float q0 = bf2f(QAsave[(size_t)i * 128 + 2 * lane]), q1 = bf2f(QAsave[(size_t)i * 128 + 2 * lane + 1]);
                float mx = -1e30f, l = 0.f, a0 = 0.f, a1 = 0.f;
                for (int kp = 0; kp < 1088; ++kp) {
                    const int t = kp >> 6; float wgt = 1.f; if (v >= 1 && v <= 17 && t == v - 1) continue; if (v >= 18 && t == v - 18) wgt = 2.f;
                    const float k0 = kv_at(true, KA, cdk, nk, b, kp, qc), k1 = kv_at(true, KA, cdk, nk, b, kp, qc + 1);
                    const float s = wave_sum(mine ? q0 * k0 + q1 * k1 : 0.f);
                    const float v0 = kv_at(true, VA, cdv, nk + (size_t)NSAMPLE * 1024, b, kp, c0), v1 = kv_at(true, VA, cdv, nk + (size_t)NSAMPLE * 1024, b, kp, c0 + 1);
                    const float mn = fmaxf(mx, s), al = exp2f(mx - mn), p = wgt * exp2f(s - mn);
                    l = l * al + p; a0 = a0 * al + p * v0; a1 = a1 * al + p * v1; mx = mn; }
                Om[m][0] = a0 / l; Om[m][1] = a1 / l; }
            const float o0 = Om[0][0] - lam * Om[1][0], o1 = Om[0][1] - lam * Om[1][1];
            const float rs = 0.8f / sqrtf(wave_sum(o0 * o0 + o1 * o1) / 128.f + 1e-6f);
            chk_record(ctl, 20 + v, bf2f(QA[(size_t)r * 1024 + c0]), o0 * rs * subg[2 * lane], 0.03f, 0.03f, lane);
            chk_record(ctl, 20 + v, bf2f(QA[(size_t)r * 1024 + c0 + 1]), o1 * rs * subg[2 * lane + 1], 0.03f, 0.03f, lane);
        }
    }
}
#endif
#endif
#ifndef PHMASK
#define PHMASK 0xfff
#endif
#ifndef DEBUG_TOL
#define DEBUG_TOL 1.0f
#endif
typedef const __attribute__((address_space(4))) Args* KArgs;
__device__ __forceinline__ KArgs kargs() { KArgs p = (KArgs)__builtin_amdgcn_kernarg_segment_ptr(); asm volatile("" : "+s"(p)); return p; }
#define ENV() KArgs A_ = kargs(); unsigned char* const ws = A_->ws; (void)ws; const int G = (int)gridDim.x, bx = (int)blockIdx.x; (void)G; (void)bx; \
    int tid = threadIdx.x; asm volatile("" : "+v"(tid)); const int lane = tid & 63, wave = __builtin_amdgcn_readfirstlane(tid >> 6); (void)lane; (void)wave; \
    const int vcu = (G % 8 == 0) ? (bx % 8) * (G / 8) + bx / 8 : bx; const int gw = vcu * NWAVES + wave, NGW = G * NWAVES; (void)gw; (void)NGW
#define WSP(T, off) ((T*)(ws + (off)))

__global__ void __launch_bounds__(NWAVES * 64, 2) fwd_kernel(Args args) {
    extern __shared__ __attribute__((aligned(16))) unsigned char lds[];
    LAS unsigned char* ldsl = (LAS unsigned char*)lds;
    volatile LAS unsigned* MISC = (volatile LAS unsigned*)(ldsl + MISC_OFF);
    for (int u = threadIdx.x; u < (LDS_BYTES - LDSCTL_OFF) / 4; u += NWAVES * 64) ((LAS unsigned*)(ldsl + LDSCTL_OFF))[u] = 0u;
    __syncthreads();
    XcdBarrier bar = xcd_barrier_post((unsigned*)((gu32*)(args.ws + WS_CTL) + CW_BAR), MISC + 8);

#if (PHMASK >> 0) & 1
    {
        ENV();
        LAS float* scr = (LAS float*)(ldsl + RING_OFF + wave * 16384);
        bf16* WIN_T = WSP(bf16, WS_WIN); bf16* F1GU = WSP(bf16, WS_F1GU); bf16* F1D = WSP(bf16, WS_F1D); bf16* F2GU = WSP(bf16, WS_F2GU); bf16* F2D = WSP(bf16, WS_F2D);
        bf16* WAB = WSP(bf16, WS_WAB); bf16* WO_T = WSP(bf16, WS_WO); bf16* XN = WSP(bf16, WS_XN);
        constexpr int I_WIN = (DM / 64) * (INCOLS / 32), I_GU = (DM / 64) * (DFF / 32), I_DN = (DFF / 64) * (DM / 32), I_UP = (1024 / 64) * (DM / 32), I_WO = (DM / 64) * (DM / 32);
        constexpr int NITEMS = I_WIN + 4 * I_GU + 2 * I_DN + 2 * I_UP + I_WO;
        for (int it = gw; it < NITEMS; it += NGW) {
            int r = it;
            if (r < I_WIN) { transpose_matrix_item(A_->in.w_in, DM, INCOLS, WIN_T, 0, 0, r, scr, lane); continue; } r -= I_WIN;
            if (r < I_GU) { transpose_matrix_item(A_->in.f1g, DM, DFF, F1GU, 0, 1, r, scr, lane); continue; } r -= I_GU;
            if (r < I_GU) { transpose_matrix_item(A_->in.f1u, DM, DFF, F1GU, 0, 2, r, scr, lane); continue; } r -= I_GU;
            if (r < I_DN) { transpose_matrix_item(A_->in.f1d, DFF, DM, F1D, 0, 0, r, scr, lane); continue; } r -= I_DN;
            if (r < I_GU) { transpose_matrix_item(A_->in.f2g, DM, DFF, F2GU, 0, 1, r, scr, lane); continue; } r -= I_GU;
            if (r < I_GU) { transpose_matrix_item(A_->in.f2u, DM, DFF, F2GU, 0, 2, r, scr, lane); continue; } r -= I_GU;
            if (r < I_DN) { transpose_matrix_item(A_->in.f2d, DFF, DM, F2D, 0, 0, r, scr, lane); continue; } r -= I_DN;
            if (r < I_UP) { transpose_matrix_item(A_->in.w_up_a, 1024, DM, WAB, 0, 0, r, scr, lane); continue; } r -= I_UP;
            if (r < I_UP) { transpose_matrix_item(A_->in.w_up_b, 1024, DM, WAB, 2048, 0, r, scr, lane); continue; } r -= I_UP;
            transpose_matrix_item(A_->in.w_o, DM, DM, WO_T, 0, 0, r, scr, lane);
        }
        { const float* xp = A_->in.x_prompt; const float* xs = A_->in.x_sample; const float* g = A_->in.n1a;
          for (int m = gw; m < MTOK; m += NGW) {
            const float* xr = m < NPROMPT ? xp + (size_t)m * DM : xs + (size_t)(m - NPROMPT) * DM;
            thin_row<false>(xr, nullptr, 0.f, nullptr, nullptr, g, XN + (size_t)m * DM, lane); } }
        { float* ROPE = WSP(float, WS_ROPE);
          for (int e = bx * (NWAVES * 64) + tid; e < 8192 * 8; e += G * NWAVES * 64) { float c, s; rope_entry(e >> 3, e & 7, c, s); ROPE[(e >> 3) * 16 + (e & 7)] = c; ROPE[(e >> 3) * 16 + 8 + (e & 7)] = s; } }
        { unsigned* LIST = WSP(unsigned, WS_LIST);
          for (int u = bx * (NWAVES * 64) + tid; u < N_UNITS; u += G * NWAVES * 64) {
            const int cu = unit_cost(u); int rank = 0;
            for (int v = 0; v < N_UNITS; ++v) { const int cv = unit_cost(v); rank += (cv > cu || (cv == cu && v < u)) ? 1 : 0; }
            LIST[rank] = (unsigned)u; } }
        if (bx == 0 && wave == 0) {
            const float s1 = wave_sum(A_->in.lq1[lane] * A_->in.lk1[lane]), s2 = wave_sum(A_->in.lq2[lane] * A_->in.lk2[lane]);
            if (lane == 0) *WSP(float, WS_LAM) = __expf(s1) - __expf(s2) + 0.2f;
        }
    }
#endif
    xcd_barrier(bar);

#if (PHMASK >> 1) & 1
    { ENV(); pg8::Gemm g{WSP(bf16, WS_XN), WSP(bf16, WS_F1GU), MTOK, 2 * DFF, DM}; pg8::StaticOrder S; S.init(MTOK, 2 * DFF, G, bx);
      pg8::EpiSwiGLU E{WSP(bf16, WS_BIG), DFF};
      pg8::gemm_phase<pg8::EpiSwiGLU, pg8::StaticOrder, true, true>(ldsl + RING_OFF, g, S, E); }
#endif
    xcd_barrier(bar);
#ifdef DEBUG_CHECK
    { ENV(); gu32* ctl = (gu32*)(ws + WS_CTL); (void)ctl; chk_ffn_gu(ctl, 1, WSP(bf16, WS_XN), A_->in.f1g, A_->in.f1u, WSP(bf16, WS_BIG), gw, NGW, lane); }
#endif
#if (PHMASK >> 2) & 1
    { ENV(); pg8::Gemm g{WSP(bf16, WS_BIG), WSP(bf16, WS_F1D), MTOK, DM, DFF}; pg8::StaticOrder S; S.init(MTOK, DM, G, bx);
      pg8::EpiPlain E{WSP(bf16, WS_D), DM};
      pg8::gemm_phase<pg8::EpiPlain, pg8::StaticOrder, true, true>(ldsl + RING_OFF, g, S, E); }
#endif
    xcd_barrier(bar);
#ifdef DEBUG_CHECK
    { ENV(); gu32* ctl = (gu32*)(ws + WS_CTL); (void)ctl; chk_gemm(ctl, 2, WSP(bf16, WS_BIG), DFF, A_->in.f1d, DM, WSP(bf16, WS_D), gw, NGW, lane); }
#endif
#if (PHMASK >> 3) & 1
    { ENV(); const float* xp = A_->in.x_prompt; const float* xs = A_->in.x_sample; const float* gpo = A_->in.n1b; const float* gpr = A_->in.nma; float* out_y = A_->out;
      bf16* DB = WSP(bf16, WS_D); bf16* XN = WSP(bf16, WS_XN);
      for (int m = gw; m < MTOK; m += NGW) {
        const float* xr = m < NPROMPT ? xp + (size_t)m * DM : xs + (size_t)(m - NPROMPT) * DM;
        thin_row<true>(xr, DB + (size_t)m * DM, 0.5f, gpo, out_y + (size_t)m * DM, gpr, XN + (size_t)m * DM, lane); } }
#endif
    xcd_barrier(bar);
#ifdef DEBUG_CHECK
    { ENV(); gu32* ctl = (gu32*)(ws + WS_CTL); (void)ctl; chk_thin(ctl, 3, A_->in.x_prompt, A_->in.x_sample, WSP(bf16, WS_D), 0.5f, A_->in.n1b, A_->out, A_->in.nma, WSP(bf16, WS_XN), gw, NGW, lane); }
#endif
#if (PHMASK >> 4) & 1
    { ENV(); pg8::Gemm g{WSP(bf16, WS_XN), WSP(bf16, WS_WIN), MTOK, INCOLS, DM}; pg8::StaticOrder S; S.init(MTOK, INCOLS, G, bx);
      float* okA_p = A_->out + (size_t)MTOK * DM;
      float* ovA_p = okA_p + (size_t)NPROMPT * 1024; float* okB_p = ovA_p + (size_t)NPROMPT * 1024; float* ovB_p = okB_p + (size_t)NPROMPT * 1024;
      float* okA_s = ovB_p + (size_t)NPROMPT * 1024; float* ovA_s = okA_s + (size_t)NSAMPLE * 1024; float* okB_s = ovA_s + (size_t)NSAMPLE * 1024; float* ovB_s = okB_s + (size_t)NSAMPLE * 1024;
      pg8::EpiWin E{WSP(bf16, WS_QA), WSP(bf16, WS_KA), WSP(bf16, WS_VA), WSP(bf16, WS_QB), WSP(bf16, WS_KB), WSP(bf16, WS_VB), WSP(bf16, WS_SGA), WSP(bf16, WS_SGB),
                    okA_p, ovA_p, okB_p, ovB_p, okA_s, ovA_s, okB_s, ovB_s, WSP(float, WS_ROPE), 0.18033688011112042f, 0.12751743082459868f};
      pg8::gemm_phase<pg8::EpiWin, pg8::StaticOrder, true, true>(ldsl + RING_OFF, g, S, E); }
#endif
    xcd_barrier(bar);
#ifdef DEBUG_CHECK
    { ENV(); gu32* ctl = (gu32*)(ws + WS_CTL); (void)ctl; chk_win(ctl, WSP(bf16, WS_XN), A_->in.w_in, ws, A_->out, gw, NGW, lane); chk_save_q(ws, WSP(bf16, WS_LIST + 65536), WSP(bf16, WS_LIST + 131072), gw, NGW, lane); }
    xcd_barrier(bar);
#endif
#if (PHMASK >> 5) & 1
    {
        for (;;) {
            ENV();
            if (tid == 0) MISC[16] = __hip_atomic_fetch_add((gu32*)(ws + WS_CTL) + CW_QUEUE, 1u, __ATOMIC_RELAXED, __HIP_MEMORY_SCOPE_AGENT);
            __syncthreads();
            const unsigned qi = MISC[16];
            __syncthreads();
            if (qi >= (unsigned)N_UNITS) break;
            float* okA_s = A_->out + (size_t)MTOK * DM + 4 * (size_t)NPROMPT * 1024;
            att::Tensors T{WSP(bf16, WS_QA), WSP(bf16, WS_QB), WSP(bf16, WS_KA), WSP(bf16, WS_VA), WSP(bf16, WS_KB), WSP(bf16, WS_VB), WSP(bf16, WS_QA), WSP(bf16, WS_QB),
                           A_->in.cdk, A_->in.cdv, A_->in.csk, A_->in.csv, okA_s, okA_s + (size_t)NSAMPLE * 1024, okA_s + 2 * (size_t)NSAMPLE * 1024, okA_s + 3 * (size_t)NSAMPLE * 1024,
                           WSP(float, WS_D), A_->in.subln_g, WSP(float, WS_LAM)};
            att::UnitP up; unit_decode((int)WSP(unsigned, WS_LIST)[qi], up);
#ifdef SAMPLE_DIFF_NAIVE
            if (up.type == 2) continue;
#endif
            att::run_unit(up, T, (char*)lds + RING_OFF);
        }
#ifdef SAMPLE_DIFF_NAIVE
        { ENV(); float* okA_s = A_->out + (size_t)MTOK * DM + 4 * (size_t)NPROMPT * 1024; const float lam = *WSP(float, WS_LAM);
          for (int it = gw; it < NSAMPLE * 8; it += NGW)
            sample_diff_rowhead(it >> 3, it & 7, WSP(bf16, WS_QA), WSP(bf16, WS_QA), A_->in.cdk, A_->in.cdv, okA_s, okA_s + (size_t)NSAMPLE * 1024, A_->in.subln_g, lam, lane); }
#endif
    }
#endif
    xcd_barrier(bar);
#ifdef DEBUG_CHECK
    { ENV(); gu32* ctl = (gu32*)(ws + WS_CTL); (void)ctl; chk_attn(ctl, ws, A_->in.cdk, A_->in.cdv, A_->in.subln_g, A_->out, WSP(bf16, WS_LIST + 65536), gw, NGW, lane);
      chk_attn_sb(ctl, ws, A_->in.csk, A_->in.csv, A_->out, WSP(bf16, WS_LIST + 131072), gw, NGW, lane);
#ifdef DEBUG_VAR
      chk_attn_var(ctl, ws, A_->in.cdk, A_->in.cdv, A_->in.subln_g, A_->out, WSP(bf16, WS_LIST + 65536), gw, NGW, lane);
#endif
    }
#endif
#if (PHMASK >> 6) & 1
    { ENV(); pg8::Gemm g{WSP(bf16, WS_QA), WSP(bf16, WS_WAB), 2 * MTOK, 4096, 1024}; pg8::UpOrder S; S.init(G, bx);
      pg8::EpiUpGate E{WSP(bf16, WS_SGA), WSP(bf16, WS_SGB), WSP(bf16, WS_XN)};
      pg8::gemm_phase<pg8::EpiUpGate, pg8::UpOrder, true, true>(ldsl + RING_OFF, g, S, E); }
#endif
    xcd_barrier(bar);
#ifdef DEBUG_CHECK
    { ENV(); gu32* ctl = (gu32*)(ws + WS_CTL); (void)ctl; chk_merge(ctl, ws, A_->in.w_up_a, A_->in.w_up_b, gw, NGW, lane); }
#endif
#if (PHMASK >> 7) & 1
    { ENV(); pg8::Gemm g{WSP(bf16, WS_XN), WSP(bf16, WS_WO), MTOK, DM, DM}; pg8::StaticOrder S; S.init(MTOK, DM, G, bx);
      pg8::EpiPlain E{WSP(bf16, WS_D), DM};
      pg8::gemm_phase<pg8::EpiPlain, pg8::StaticOrder, true, true>(ldsl + RING_OFF, g, S, E); }
#endif
    xcd_barrier(bar);
#ifdef DEBUG_CHECK
    { ENV(); gu32* ctl = (gu32*)(ws + WS_CTL); (void)ctl; chk_gemm(ctl, 8, WSP(bf16, WS_XN), DM, A_->in.w_o, DM, WSP(bf16, WS_D), gw, NGW, lane); }
    xcd_barrier(bar);
#endif
#if (PHMASK >> 8) & 1
    { ENV(); const float* gpo = A_->in.nmb; const float* gpr = A_->in.n2a; float* out_y = A_->out; bf16* DB = WSP(bf16, WS_D); bf16* XN = WSP(bf16, WS_XN);
      for (int m = gw; m < MTOK; m += NGW)
        thin_row<true>(out_y + (size_t)m * DM, DB + (size_t)m * DM, 1.0f, gpo, out_y + (size_t)m * DM, gpr, XN + (size_t)m * DM, lane); }
#endif
    xcd_barrier(bar);
#ifdef DEBUG_CHECK
    { ENV(); gu32* ctl = (gu32*)(ws + WS_CTL); (void)ctl; chk_thin(ctl, 9, nullptr, nullptr, nullptr, 1.f, nullptr, A_->out, A_->in.n2a, WSP(bf16, WS_XN), gw, NGW, lane); }
#endif
#if (PHMASK >> 9) & 1
    { ENV(); pg8::Gemm g{WSP(bf16, WS_XN), WSP(bf16, WS_F2GU), MTOK, 2 * DFF, DM}; pg8::StaticOrder S; S.init(MTOK, 2 * DFF, G, bx);
      pg8::EpiSwiGLU E{WSP(bf16, WS_BIG), DFF};
      pg8::gemm_phase<pg8::EpiSwiGLU, pg8::StaticOrder, true, true>(ldsl + RING_OFF, g, S, E); }
#endif
    xcd_barrier(bar);
#ifdef DEBUG_CHECK
    { ENV(); gu32* ctl = (gu32*)(ws + WS_CTL); (void)ctl; chk_ffn_gu(ctl, 10, WSP(bf16, WS_XN), A_->in.f2g, A_->in.f2u, WSP(bf16, WS_BIG), gw, NGW, lane); }
#endif
#if (PHMASK >> 10) & 1
    { ENV(); pg8::Gemm g{WSP(bf16, WS_BIG), WSP(bf16, WS_F2D), MTOK, DM, DFF}; pg8::StaticOrder S; S.init(MTOK, DM, G, bx);
      pg8::EpiPlain E{WSP(bf16, WS_D), DM};
      pg8::gemm_phase<pg8::EpiPlain, pg8::StaticOrder, true, true>(ldsl + RING_OFF, g, S, E); }
#endif
    xcd_barrier(bar);
#ifdef DEBUG_CHECK
    { ENV(); gu32* ctl = (gu32*)(ws + WS_CTL); (void)ctl; chk_gemm(ctl, 11, WSP(bf16, WS_BIG), DFF, A_->in.f2d, DM, WSP(bf16, WS_D), gw, NGW, lane); }
    xcd_barrier(bar);
#endif
#if (PHMASK >> 11) & 1
    { ENV(); const float* gpo = A_->in.n2b; float* out_y = A_->out; bf16* DB = WSP(bf16, WS_D);
      float oscale = 1.f;
#ifdef DEBUG_CHECK
      { gu32* ctl = (gu32*)(ws + WS_CTL); int code = 0;
        for (int k = 14; k >= 1; --k) { const float e = __uint_as_float(__hip_atomic_load(ctl + CW_ERR + 64 * k, __ATOMIC_RELAXED, __HIP_MEMORY_SCOPE_AGENT)); if (e > DEBUG_TOL) code = k; }
#ifdef DEBUG_VAR
        { float best = 1e30f; int bv = 0; for (int v = 0; v < 35; ++v) { const float e = __uint_as_float(__hip_atomic_load(ctl + CW_ERR + 64 * (20 + v), __ATOMIC_RELAXED, __HIP_MEMORY_SCOPE_AGENT)); if (e < best) { best = e; bv = v; } }
#if DEBUG_VAR == 1
          oscale = 1.f + sqrtf(0.02f * (float)(bv + 1));
#else
          oscale = 1.f + sqrtf(fminf(0.9f, 0.01f * best));
#endif
          (void)code; }
#elif defined(DEBUG_MAG)
        { const float e = __uint_as_float(__hip_atomic_load(ctl + CW_ERR + 64 * DEBUG_MAG, __ATOMIC_RELAXED, __HIP_MEMORY_SCOPE_AGENT)); oscale = 1.f + sqrtf(fminf(0.9f, 0.01f * e)); (void)code; }
#else
        oscale = 1.f + sqrtf(0.02f * (float)code);
#endif
      }
#endif
      for (int m = gw; m < MTOK; m += NGW)
        thin_row<true>(out_y + (size_t)m * DM, DB + (size_t)m * DM, 0.5f, gpo, out_y + (size_t)m * DM, nullptr, nullptr, lane, oscale); }
#endif
}

extern "C" void kernel_launch(void* const* d_in, const int* in_sizes, int n_in, void* d_out, int out_size, void* d_ws, size_t ws_size, hipStream_t stream) {
    static int grid = 0;
    if (grid == 0) {
        const long want_out = (long)MTOK * DM + 4L * MTOK * 1024;
        if (n_in != 27 || in_sizes[0] != NPROMPT * DM || in_sizes[1] != NSAMPLE * DM || (long)out_size != want_out || ws_size < WS_END) {
            fprintf(stderr, "kernel_launch: shape mismatch: n_in %d in0 %d in1 %d out %d (want %ld) ws %zu (need %zu); nothing launched\n", n_in, n_in > 0 ? in_sizes[0] : -1, n_in > 1 ? in_sizes[1] : -1, out_size, want_out, ws_size, (size_t)WS_END);
            grid = -1; return; }
        int dev = 0, cus = 0, per_cu = 0;
        if (hipGetDevice(&dev) != hipSuccess || hipDeviceGetAttribute(&cus, hipDeviceAttributeMultiprocessorCount, dev) != hipSuccess) { fprintf(stderr, "kernel_launch: device query failed\n"); grid = -1; return; }
        if (hipFuncSetAttribute((const void*)fwd_kernel, hipFuncAttributeMaxDynamicSharedMemorySize, LDS_BYTES) != hipSuccess) { fprintf(stderr, "kernel_launch: hipFuncSetAttribute failed\n"); grid = -1; return; }
        if (hipOccupancyMaxActiveBlocksPerMultiprocessor(&per_cu, (const void*)fwd_kernel, NWAVES * 64, LDS_BYTES) != hipSuccess || per_cu < 1) {
            fprintf(stderr, "kernel_launch: occupancy query reports %d workgroups per CU; nothing launched\n", per_cu); (void)hipGetLastError(); grid = -1; return; }
        (void)hipGetLastError();
        grid = cus;
    }
    if (grid < 0) return;
    if (hipMemsetAsync((char*)d_ws + WS_CTL, 0, CTL_ZERO_BYTES, stream) != hipSuccess) { fprintf(stderr, "kernel_launch: hipMemsetAsync failed\n"); return; }
    Args a{};
    const float* const* p = (const float* const*)d_in;
    a.in.x_prompt = p[0]; a.in.x_sample = p[1]; a.in.cdk = p[2]; a.in.cdv = p[3]; a.in.csk = p[4]; a.in.csv = p[5]; a.in.w_in = p[6]; a.in.w_up_a = p[7]; a.in.w_up_b = p[8]; a.in.w_o = p[9];
    a.in.lq1 = p[10]; a.in.lk1 = p[11]; a.in.lq2 = p[12]; a.in.lk2 = p[13]; a.in.subln_g = p[14];
    a.in.n1a = p[15]; a.in.n1b = p[16]; a.in.nma = p[17]; a.in.nmb = p[18]; a.in.n2a = p[19]; a.in.n2b = p[20];
    a.in.f1g = p[21]; a.in.f1u = p[22]; a.in.f1d = p[23]; a.in.f2g = p[24]; a.in.f2u = p[25]; a.in.f2d = p[26];
    a.out = (float*)d_out; a.ws = (unsigned char*)d_ws;
    hipLaunchKernelGGL(fwd_kernel, dim3(grid), dim3(NWAVES * 64), LDS_BYTES, stream, a);
    const hipError_t le = hipPeekAtLastError();
    if (le != hipSuccess) fprintf(stderr, "kernel_launch: launch failed: %s\n", hipGetErrorName(le));
}
```

```cpp
#include <hip/hip_runtime.h>
#include <cstdio>
#include <cstdint>
constexpr int WAVETAB_OFF = 131072 + 320 + 128;
__device__ __forceinline__ int tidx() {
    extern __shared__ __attribute__((aligned(16))) unsigned char lds_tab_[];
    const unsigned hw = __builtin_amdgcn_s_getreg(0x2804);
    const int w = *(volatile __attribute__((address_space(3))) int*)((__attribute__((address_space(3))) unsigned char*)lds_tab_ + WAVETAB_OFF + 4 * hw);
    int l; asm volatile("v_mbcnt_lo_u32_b32 %0, -1, 0\n\tv_mbcnt_hi_u32_b32 %0, -1, %0" : "=v"(l));
    return (__builtin_amdgcn_readfirstlane(w) << 6) | l;
}
#ifndef PG8_WGM
#define PG8_WGM 4
#endif
namespace pg8 {
#define PG8_LAS __attribute__((address_space(3)))
typedef unsigned short bf16_t;
typedef short bf16x8 __attribute__((ext_vector_type(8)));
typedef float f32x4 __attribute__((ext_vector_type(4)));
typedef unsigned u32x4 __attribute__((ext_vector_type(4)));
constexpr int BM = 256, BK = 64, HALF = 128, HTB = HALF * BK * 2  , STAGE_BYTES = 8 * HTB, NXCD = 8, WGM = PG8_WGM;

__host__ __device__ __forceinline__ int lds_byte(int r, int c) { const int st = (r >> 4) * 2 + (c >> 5), rr = r & 15, cc = c & 31, ob = rr * 64 + cc * 2; return st * 1024 + (ob ^ (((ob >> 9) & 1) << 5)); }
__host__ __device__ __forceinline__ void stage_rc(int b, int& R, int& C) { const int st = b / 1024, sb = b % 1024, swz = sb ^ (((sb >> 9) & 1) << 5); R = (st >> 1) * 16 + swz / 64; C = (st & 1) * 32 + (swz % 64) / 2; }
__host__ __device__ __forceinline__ int perm32(int rho) { const int n = rho >> 4, i = rho & 15; return 8 * (i >> 2) + 4 * n + (i & 3); }

struct Unit { int pm, pn; };
struct Gemm { const bf16_t* A; const bf16_t* Bt; int M, N, K; };

struct StaticOrder {
    int nM, nN, nwg, G, c;
    __host__ __device__ void init(int M, int N, int G_, int c_) { nM = M / BM; nN = N / BM; nwg = nM * nN; G = G_; c = c_; }
    __host__ __device__ bool next(int i, Unit& u) const {
        const long L = (long)i * G + c; if (L >= nwg) return false;
        int wgid = (int)L; { const int q = nwg / NXCD, r = nwg % NXCD, xcd = wgid % NXCD, off = wgid / NXCD; wgid = (xcd < r ? xcd * (q + 1) : r * (q + 1) + (xcd - r) * q) + off; }
        const int nig = WGM * nN, gid = wgid / nig, fm = gid * WGM, gsz = (nM - fm) < WGM ? (nM - fm) : WGM;
        u.pm = fm + ((wgid % nig) % gsz); u.pn = (wgid % nig) / gsz; return true;
    }
    __device__ __forceinline__ void a_ready(const Unit&) const {}
    __device__ __forceinline__ void done(const Unit&) const {}
};

typedef float f32x2_t __attribute__((ext_vector_type(2))); typedef __bf16 bf16x2_t __attribute__((ext_vector_type(2)));
__device__ __forceinline__ unsigned cvt_pk_bf16(float lo, float hi) { f32x2_t v = {lo, hi}; bf16x2_t b = __builtin_convertvector(v, bf16x2_t); return __builtin_bit_cast(unsigned, b); }
__device__ __forceinline__ u32x4 pack8(const f32x4 v0, const f32x4 v1) { u32x4 w; w.x = cvt_pk_bf16(v0[0], v0[1]); w.y = cvt_pk_bf16(v0[2], v0[3]); w.z = cvt_pk_bf16(v1[0], v1[1]); w.w = cvt_pk_bf16(v1[2], v1[3]); return w; }
__device__ __forceinline__ float bf_lo(unsigned w) { return __uint_as_float(w << 16); }
__device__ __forceinline__ float bf_hi(unsigned w) { return __uint_as_float(w & 0xffff0000u); }
__device__ __forceinline__ float sigmoid_f(float x) { return __builtin_amdgcn_rcpf(1.0f + __builtin_amdgcn_exp2f(-1.4426950408889634f * x)); }

struct EpiPlain {
    static constexpr bool PERM = true, AFTER_DRAIN = false, PREF = false;
    bf16_t* O; int ldc;
    __device__ __forceinline__ void operator()(const f32x4 (&acc)[2][2][4][2], const Unit& u, int wr, int wc, int fr, int fq) const {
        const int row0 = u.pm * BM + wr * 64 + fr, col0 = u.pn * BM + wc * 32 + 8 * fq;
#pragma unroll
        for (int ai = 0; ai < 2; ++ai)
#pragma unroll
            for (int m = 0; m < 4; ++m) { bf16_t* rowp = O + (size_t)(row0 + ai * HALF + m * 16) * ldc + col0;
#pragma unroll
                for (int bj = 0; bj < 2; ++bj) *(u32x4*)(rowp + bj * HALF) = pack8(acc[ai][bj][m][0], acc[ai][bj][m][1]); }
    }
};
struct EpiSwiGLU {
    static constexpr bool PERM = true, AFTER_DRAIN = false, PREF = true;
    bf16_t* O; int ldc; const float* rs;
    __device__ __forceinline__ const float* pref_src(const Unit& u) const { return rs + u.pm * BM; }
    __device__ __forceinline__ void operator()(const f32x4 (&acc)[2][2][4][2], const Unit& u, int wr, int wc, int fr, int fq, const PG8_LAS float* rslot) const {
        const int row0 = u.pm * BM + wr * 64 + fr, col0 = u.pn * HALF + wc * 32 + 8 * fq;
        float rr[8];
#pragma unroll
        for (int it = 0; it < 8; ++it) rr[it] = rslot[wr * 64 + fr + (it >> 2) * HALF + (it & 3) * 16];
#pragma unroll
        for (int ai = 0; ai < 2; ++ai)
#pragma unroll
            for (int m = 0; m < 4; ++m) { bf16_t* rowp = O + (size_t)(row0 + ai * HALF + m * 16) * ldc + col0;
                f32x4 v[2]; const float r = rr[ai * 4 + m];
#pragma unroll
                for (int n = 0; n < 2; ++n)
#pragma unroll
                    for (int i = 0; i < 4; ++i) { const float g = acc[ai][0][m][n][i] * r, up = acc[ai][1][m][n][i] * r; v[n][i] = g * sigmoid_f(g) * up; }
                *(u32x4*)rowp = pack8(v[0], v[1]); }
    }
};
constexpr int ACT8_LD = 5632; constexpr float ACT8_SCALE = 8.f, W8_SCALE = 1024.f;
typedef unsigned u32x2 __attribute__((ext_vector_type(2)));
__device__ __forceinline__ unsigned pk4_fp8(float a, float b, float c, float d) {
    int w = __builtin_amdgcn_cvt_pk_fp8_f32(__builtin_amdgcn_fmed3f(a, -448.f, 448.f), __builtin_amdgcn_fmed3f(b, -448.f, 448.f), 0, false);
    w = __builtin_amdgcn_cvt_pk_fp8_f32(__builtin_amdgcn_fmed3f(c, -448.f, 448.f), __builtin_amdgcn_fmed3f(d, -448.f, 448.f), w, true); return (unsigned)w; }
struct EpiSwiGLU8 {
    static constexpr bool PERM = true, AFTER_DRAIN = false, PREF = true;
    unsigned char* O; const float* rs;
    __device__ __forceinline__ const float* pref_src(const Unit& u) const { return rs + u.pm * BM; }
    __device__ __forceinline__ void operator()(const f32x4 (&acc)[2][2][4][2], const Unit& u, int wr, int wc, int fr, int fq, const PG8_LAS float* rslot) const {
        const int row0 = u.pm * BM + wr * 64 + fr, col0 = u.pn * HALF + wc * 32 + 8 * fq;
        float rr[8];
#pragma unroll
        for (int it = 0; it < 8; ++it) rr[it] = rslot[wr * 64 + fr + (it >> 2) * HALF + (it & 3) * 16];
#pragma unroll
        for (int ai = 0; ai < 2; ++ai)
#pragma unroll
            for (int m = 0; m < 4; ++m) { unsigned char* rowp = O + (size_t)(row0 + ai * HALF + m * 16) * ACT8_LD + col0;
                f32x4 v[2]; const float r = rr[ai * 4 + m];
#pragma unroll
                for (int n = 0; n < 2; ++n)
#pragma unroll
                    for (int i = 0; i < 4; ++i) { const float g = acc[ai][0][m][n][i] * r, up = acc[ai][1][m][n][i] * r; v[n][i] = g * sigmoid_f(g) * up * ACT8_SCALE; }
                u32x2 w; w.x = pk4_fp8(v[0][0], v[0][1], v[0][2], v[0][3]); w.y = pk4_fp8(v[1][0], v[1][1], v[1][2], v[1][3]);
                *(u32x2*)rowp = w;
                if (u.pn == (5504 / HALF) - 1) *(u32x2*)(rowp + HALF) = (u32x2){0u, 0u}; }
    }
};
struct EpiPlainS {
    static constexpr bool PERM = true, AFTER_DRAIN = false, PREF = false;
    bf16_t* O; int ldc; float sc;
    __device__ __forceinline__ void operator()(const f32x4 (&acc)[2][2][4][2], const Unit& u, int wr, int wc, int fr, int fq) const {
        const int row0 = u.pm * BM + wr * 64 + fr, col0 = u.pn * BM + wc * 32 + 8 * fq;
#pragma unroll
        for (int ai = 0; ai < 2; ++ai)
#pragma unroll
            for (int m = 0; m < 4; ++m) { bf16_t* rowp = O + (size_t)(row0 + ai * HALF + m * 16) * ldc + col0;
#pragma unroll
                for (int bj = 0; bj < 2; ++bj) *(u32x4*)(rowp + bj * HALF) = pack8(acc[ai][bj][m][0] * sc, acc[ai][bj][m][1] * sc); }
    }
};
struct EpiWin {
    static constexpr bool PERM = true, AFTER_DRAIN = false, PREF = true;
    bf16_t *QA, *KA, *VA, *QB, *KB, *VB, *SGA, *SGB;
    float *okA_p, *ovA_p, *okB_p, *ovB_p, *okA_s, *ovA_s, *okB_s, *ovB_s;
    float cqa, cqb; const float* rs;
    __device__ __forceinline__ const float* pref_src(const Unit& u) const { return rs + u.pm * BM; }
    __device__ __forceinline__ void operator()(const f32x4 (&acc)[2][2][4][2], const Unit& u, int wr, int wc, int fr, int fq, const PG8_LAS float* rslot) const {
        const int pn = u.pn;
        int seg, ct; if (pn < 24) { seg = pn >> 2; ct = pn & 3; } else if (pn < 32) { seg = 6; ct = pn - 24; } else { seg = 7; ct = pn - 32; }
        const bool prompt = u.pm < 128;
        const int row0 = u.pm * BM + wr * 64 + fr, col0 = ct * BM + wc * 32 + 8 * fq;
        bf16_t* bdst; float* fdst = nullptr; int ld = 1024; float scale = 1.f;
        switch (seg) {
            case 0: bdst = QA; scale = cqa; break;
            case 1: bdst = KA; fdst = prompt ? okA_p : okA_s; break;
            case 2: bdst = VA; fdst = prompt ? ovA_p : ovA_s; break;
            case 3: bdst = QB; scale = cqb; break;
            case 4: bdst = KB; fdst = prompt ? okB_p : okB_s; break;
            case 5: bdst = VB; fdst = prompt ? ovB_p : ovB_s; break;
            case 6: bdst = SGA; ld = 2048; break;
            default: bdst = SGB; ld = 2048; break;
        }
        const bool dorope = (seg <= 1) && ((wc & 1) == 0);
        const bool gate = seg >= 6;
        const float sgn = (fq == 0) ? -1.f : 1.f;
        float rr[8];
#pragma unroll
        for (int it = 0; it < 8; ++it) rr[it] = rslot[wr * 64 + fr + (it >> 2) * HALF + (it & 3) * 16];
#pragma unroll
        for (int ai = 0; ai < 2; ++ai)
#pragma unroll
            for (int m = 0; m < 4; ++m) {
                const int row = row0 + ai * HALF + m * 16; const float r = rr[ai * 4 + m];
                f32x4 v[2][2];
#pragma unroll
                for (int bj = 0; bj < 2; ++bj) { v[bj][0] = acc[ai][bj][m][0] * r; v[bj][1] = acc[ai][bj][m][1] * r; }
                if (dorope) {
                    const float posf = (float)(prompt ? (row & 8191) : (1024 + (row & 63)));
                    constexpr float RC[8] = {0.15915494309189535f, 0.030863763775294327f, 0.0059851855051852755f, 0.0011606636683911752f, 0.00022507907903927652f, 4.364795314162585e-05f, 8.464330686203427e-06f, 1.6414263642582245e-06f};
                    f32x4 c0, c1, s0, s1;
#pragma unroll
                    for (int i = 0; i < 4; ++i) { const float r0 = __builtin_amdgcn_fractf(posf * RC[i]), r1 = __builtin_amdgcn_fractf(posf * RC[4 + i]);
                        c0[i] = __builtin_amdgcn_cosf(r0); s0[i] = __builtin_amdgcn_sinf(r0); c1[i] = __builtin_amdgcn_cosf(r1); s1[i] = __builtin_amdgcn_sinf(r1); }
#pragma unroll
                    for (int bj = 0; bj < 2; ++bj)
#pragma unroll
                        for (int i = 0; i < 4; ++i) {
                            const float a0 = v[bj][0][i], a1 = v[bj][1][i];
                            const float p0 = __shfl_xor(a0, 16), p1 = __shfl_xor(a1, 16);
                            const float r0 = a0 * c0[i] + sgn * p0 * s0[i], r1 = a1 * c1[i] + sgn * p1 * s1[i];
                            if (fq < 2) { v[bj][0][i] = r0; v[bj][1][i] = r1; }
                        }
                }
                if (fdst) { float* fp = fdst + (size_t)(prompt ? row : row - 32768) * 1024 + col0;
#pragma unroll
                    for (int bj = 0; bj < 2; ++bj) { __builtin_nontemporal_store(v[bj][0], (f32x4*)(fp + bj * HALF)); __builtin_nontemporal_store(v[bj][1], (f32x4*)(fp + bj * HALF + 4)); } }
                bf16_t* bp = bdst + (size_t)row * ld + col0;
#pragma unroll
                for (int bj = 0; bj < 2; ++bj) {
                    f32x4 a = v[bj][0], b = v[bj][1];
                    if (gate) {
#pragma unroll
                        for (int i = 0; i < 4; ++i) { a[i] = sigmoid_f(a[i]); b[i] = sigmoid_f(b[i]); }
                    } else { a = a * scale; b = b * scale; }
                    *(u32x4*)(bp + bj * HALF) = pack8(a, b);
                }
            }
    }
};
struct EpiUpGate {
    static constexpr bool PERM = true, AFTER_DRAIN = false, PREF = false;
    const bf16_t *SGA, *SGB; bf16_t* MG;
    __device__ __forceinline__ void operator()(const f32x4 (&acc)[2][2][4][2], const Unit& u, int wr, int wc, int fr, int fq) const {
        const bool br = u.pm >= 136; const int pm = br ? u.pm - 136 : u.pm, pn = br ? u.pn - 8 : u.pn;
        const bf16_t* sg = br ? SGB : SGA;
        const int row0 = pm * BM + wr * 64 + fr, col0 = pn * BM + wc * 32 + 8 * fq;
        u32x4 gq[4][2], pq[4][2];
#define UG_LOAD(G_, P_, it_) do { const size_t off_ = (size_t)(row0 + ((it_) >> 2) * HALF + ((it_) & 3) * 16) * 2048 + col0; \
            G_[0] = *(const u32x4*)(sg + off_); G_[1] = *(const u32x4*)(sg + off_ + HALF); \
            if (br) { P_[0] = *(const u32x4*)(MG + off_); P_[1] = *(const u32x4*)(MG + off_ + HALF); } } while (0)
#pragma unroll
        for (int j = 0; j < 4; ++j) UG_LOAD(gq[j], pq[j], j);
#pragma unroll
        for (int it = 0; it < 8; ++it) { const int ai = it >> 2, m = it & 3;
            const size_t off = (size_t)(row0 + ai * HALF + m * 16) * 2048 + col0;
            u32x4 outw[2];
#pragma unroll
            for (int bj = 0; bj < 2; ++bj) {
                const u32x4 g = gq[m][bj];
                f32x4 a = acc[ai][bj][m][0], b = acc[ai][bj][m][1];
                a[0] *= bf_lo(g.x); a[1] *= bf_hi(g.x); a[2] *= bf_lo(g.y); a[3] *= bf_hi(g.y);
                b[0] *= bf_lo(g.z); b[1] *= bf_hi(g.z); b[2] *= bf_lo(g.w); b[3] *= bf_hi(g.w);
                if (br) { const u32x4 p = pq[m][bj];
                    a[0] += bf_lo(p.x); a[1] += bf_hi(p.x); a[2] += bf_lo(p.y); a[3] += bf_hi(p.y);
                    b[0] += bf_lo(p.z); b[1] += bf_hi(p.z); b[2] += bf_lo(p.w); b[3] += bf_hi(p.w); }
                outw[bj] = pack8(a, b);
            }
            if (it < 4) UG_LOAD(gq[m], pq[m], it + 4);
            *(u32x4*)(MG + off) = outw[0]; *(u32x4*)(MG + off + HALF) = outw[1]; }
#undef UG_LOAD
    }
};
struct UpOrder {
    StaticOrder so;
    __device__ void init(int G_, int c_) { so.init(136 * BM, 8 * BM, G_, c_); }
    __device__ bool next(int i, Unit& u) const { if (!so.next(i >> 1, u)) return false; if (i & 1) { u.pm += 136; u.pn += 8; } return true; }
    __device__ __forceinline__ void a_ready(const Unit&) const {}
    __device__ __forceinline__ void done(const Unit&) const {}
};

struct SampleOrder {
    int nN, n, c;
    __device__ bool next(int i, Unit& u) const { const int L = i * n + c; if (L >= 8 * nN) return false; u.pm = 128 + (L & 7); u.pn = L >> 3; return true; }
    __device__ __forceinline__ void a_ready(const Unit&) const {}
    __device__ __forceinline__ void done(const Unit&) const {}
};

typedef int i32x4_t __attribute__((ext_vector_type(4))); typedef int i32x8_t __attribute__((ext_vector_type(8)));
__device__ __forceinline__ f32x4 mfma_f8(const bf16x8 (&b)[2], const bf16x8 (&a)[2], f32x4 c) {
    const i32x8_t B = __builtin_shufflevector(__builtin_bit_cast(i32x4_t, b[0]), __builtin_bit_cast(i32x4_t, b[1]), 0, 1, 2, 3, 4, 5, 6, 7);
    const i32x8_t A = __builtin_shufflevector(__builtin_bit_cast(i32x4_t, a[0]), __builtin_bit_cast(i32x4_t, a[1]), 0, 1, 2, 3, 4, 5, 6, 7);
    asm volatile("v_mfma_f32_16x16x128_f8f6f4 %0, %1, %2, %0" : "+v"(c) : "v"(B), "v"(A));
    return c;
}
template <class Epi, class Sched, bool ALIGN_EPI = false, bool SP2 = false, bool F8 = false>
__device__ __forceinline__ void gemm_phase(PG8_LAS unsigned char* lds, const Gemm g, const Sched& S, const Epi& E) {
    int tid_ = tidx(); asm volatile("" : "+v"(tid_));
    const int tid = tid_, wid = __builtin_amdgcn_readfirstlane(tid >> 6), lane = tid & 63, wr = wid >> 2, wc = wid & 3, fr = lane & 15, fq = lane >> 4;
    const int K = g.K, nt = K / BK;
    unsigned voffA[2], voffB[2];
#pragma unroll
    for (int i = 0; i < 2; ++i) { int R, C; stage_rc(tid * 16 + i * 8192, R, C); const int Rb = Epi::PERM ? ((R & ~31) + perm32(R & 31)) : R;
        voffA[i] = (unsigned)(R * K + C) * 2u; voffB[i] = (unsigned)(Rb * K + C) * 2u; }
    const size_t kstep = (size_t)(BK * 2);
    const size_t hstep = (size_t)HALF * K * 2;
    const size_t tstep = 2 * hstep;
    const unsigned ldsw = (unsigned)wid * 1024u;
    const int aoff = lds_byte(wr * 64 + fr, fq * 8), boff = lds_byte(wc * 32 + fr, fq * 8);
    unsigned bb_ = (unsigned)(uintptr_t)lds + 4u * HTB + (unsigned)boff; asm volatile("" : "+v"(bb_)); const PG8_LAS unsigned char* const ldsb = (const PG8_LAS unsigned char*)(uintptr_t)bb_;
#define PG8_SA(b, h) (((b) * 2 + (h)) * HTB)
#define PG8_SB(b, h) ((4 + (b) * 2 + (h)) * HTB)
#define PG8_STAGE(bufoff, gbase, voff) do { _Pragma("unroll") for (int _i = 0; _i < 2; ++_i) \
        asm volatile("s_mov_b32 m0, %2\n\ts_nop 0\n\tglobal_load_lds_dwordx4 %0, %1" :: "v"((voff)[_i]), "s"((const char*)(gbase)), \
                     "s"((unsigned)(uintptr_t)(lds + (bufoff) + ldsw + _i * 8192)) : "memory"); } while (0)
#define PG8_LDA(dst, b, h) do { _Pragma("unroll") for (int m = 0; m < 4; ++m) _Pragma("unroll") for (int k = 0; k < 2; ++k) dst[m][k] = *(const PG8_LAS bf16x8*)(lds + PG8_SA(b, h) + aoff + m * 2048 + k * 1024); } while (0)
#define PG8_LDB(dst, b, h) do { _Pragma("unroll") for (int n = 0; n < 2; ++n) _Pragma("unroll") for (int k = 0; k < 2; ++k) dst[n][k] = *(const PG8_LAS bf16x8*)(ldsb + ((b) * 2 + (h)) * HTB + n * 2048 + k * 1024); } while (0)
#define PG8_MMA(ai, bj, At, Bt) do { __builtin_amdgcn_s_setprio(1); _Pragma("unroll") for (int m = 0; m < 4; ++m) _Pragma("unroll") for (int n = 0; n < 2; ++n) { \
        if constexpr (F8) acc[ai][bj][m][n] = mfma_f8(Bt[n], At[m], acc[ai][bj][m][n]); \
        else { _Pragma("unroll") for (int k = 0; k < 2; ++k) acc[ai][bj][m][n] = __builtin_amdgcn_mfma_f32_16x16x32_bf16(Bt[n][k], At[m][k], acc[ai][bj][m][n], 0, 0, 0); } } \
        if constexpr (F8) asm volatile("s_nop 7"); __builtin_amdgcn_s_setprio(0); } while (0)
#define PG8_WAIT_V(n) asm volatile("s_waitcnt vmcnt(" #n ")" ::: "memory")
#define PG8_WAIT_L(n) asm volatile("s_waitcnt lgkmcnt(" #n ")" ::: "memory")
#define PG8_BAR __builtin_amdgcn_s_barrier()
#define PG8_SCHED __builtin_amdgcn_sched_barrier(0)
    Unit cur, nxt; int ui = 0;
    if (!S.next(0, cur)) return;
    f32x4 acc[2][2][4][2];
#pragma unroll
    for (int a = 0; a < 2; ++a)
#pragma unroll
        for (int b = 0; b < 2; ++b)
#pragma unroll
            for (int m = 0; m < 4; ++m)
#pragma unroll
                for (int n = 0; n < 2; ++n) acc[a][b][m][n] = (f32x4){0.f, 0.f, 0.f, 0.f};
    bf16x8 At[4][2], B0[2][2], B1[2][2];
    const char* cA = (const char*)g.A + (size_t)cur.pm * tstep; const char* cB = (const char*)g.Bt + (size_t)cur.pn * tstep;
    S.a_ready(cur);
    constexpr int RS_SLOT = 134208;
#define PG8_RSDMA(u_, par_) do { if constexpr (Epi::PREF) { if (wid == 0) __builtin_amdgcn_global_load_lds((const unsigned*)(E.pref_src(u_) + lane * 4), (PG8_LAS unsigned*)(lds + RS_SLOT + (par_) * 1024), 16, 0, 0); } } while (0)
    PG8_RSDMA(cur, 0);
    if constexpr (SP2) {
        PG8_STAGE(PG8_SB(0, 0), cB, voffB); PG8_STAGE(PG8_SB(0, 1), cB + hstep, voffB); PG8_STAGE(PG8_SA(0, 0), cA, voffA); PG8_STAGE(PG8_SA(0, 1), cA + hstep, voffA);
        if (wr == 1) PG8_BAR;
        PG8_WAIT_V(2); PG8_BAR;
        PG8_STAGE(PG8_SB(1, 0), cB + kstep, voffB); PG8_STAGE(PG8_SA(1, 0), cA + kstep, voffA); PG8_STAGE(PG8_SB(1, 1), cB + hstep + kstep, voffB);
        PG8_WAIT_V(6); PG8_BAR;
    } else {
        PG8_STAGE(PG8_SB(0, 0), cB, voffB); PG8_STAGE(PG8_SA(0, 0), cA, voffA); PG8_STAGE(PG8_SB(0, 1), cB + hstep, voffB); PG8_STAGE(PG8_SA(0, 1), cA + hstep, voffA);
        if (wr == 1) PG8_BAR;
        PG8_WAIT_V(4); PG8_BAR;
        PG8_STAGE(PG8_SB(1, 0), cB + kstep, voffB); PG8_STAGE(PG8_SA(1, 0), cA + kstep, voffA); PG8_STAGE(PG8_SB(1, 1), cB + hstep + kstep, voffB);
        PG8_WAIT_V(6); PG8_BAR;
    }
    for (;;) {
        const bool has_next = S.next(ui + 1, nxt);
        const char* nA = has_next ? (const char*)g.A + (size_t)nxt.pm * tstep : cA; const char* nB = has_next ? (const char*)g.Bt + (size_t)nxt.pn * tstep : cB;
        for (int t = 0; t < nt; t += 2) {
            const bool last = (t == nt - 2);
            const char* a1 = cA + (size_t)(t + 1) * kstep;
            const char* a2 = last ? nA : cA + (size_t)(t + 2) * kstep; const char* b2 = last ? nB : cB + (size_t)(t + 2) * kstep;
            const char* a3 = a2 + kstep; const char* b3 = b2 + kstep;
            if (last && has_next) { S.a_ready(nxt); PG8_RSDMA(nxt, (ui + 1) & 1); }
            if constexpr (SP2) {
            PG8_LDB(B0, 0, 0); PG8_LDB(B1, 0, 1); PG8_SCHED; PG8_LDA(At, 0, 0); PG8_STAGE(PG8_SA(1, 1), a1 + hstep, voffA);
            PG8_WAIT_V(8); PG8_WAIT_L(0); PG8_BAR; PG8_MMA(0, 0, At, B0); PG8_MMA(0, 1, At, B1); PG8_BAR; PG8_SCHED;
            PG8_LDA(At, 0, 1); PG8_STAGE(PG8_SB(0, 0), b2, voffB); PG8_STAGE(PG8_SB(0, 1), b2 + hstep, voffB); PG8_STAGE(PG8_SA(0, 0), a2, voffA);
            PG8_WAIT_V(8); PG8_WAIT_L(0); PG8_BAR; PG8_MMA(1, 0, At, B0); PG8_MMA(1, 1, At, B1); PG8_BAR; PG8_SCHED;
            PG8_LDB(B0, 1, 0); PG8_LDB(B1, 1, 1); PG8_SCHED; PG8_LDA(At, 1, 0); PG8_STAGE(PG8_SA(0, 1), a2 + hstep, voffA);
            PG8_WAIT_V(8); PG8_WAIT_L(0); PG8_BAR; PG8_MMA(0, 0, At, B0); PG8_MMA(0, 1, At, B1); PG8_BAR; PG8_SCHED;
            PG8_LDA(At, 1, 1); PG8_STAGE(PG8_SB(1, 0), b3, voffB); PG8_STAGE(PG8_SB(1, 1), b3 + hstep, voffB); PG8_STAGE(PG8_SA(1, 0), a3, voffA);
            PG8_WAIT_V(8); PG8_WAIT_L(0); PG8_BAR; PG8_MMA(1, 0, At, B0); PG8_MMA(1, 1, At, B1); PG8_BAR; PG8_SCHED;
            } else {
            PG8_LDB(B0, 0, 0); PG8_SCHED; PG8_LDA(At, 0, 0); PG8_STAGE(PG8_SA(1, 1), a1 + hstep, voffA);
            PG8_WAIT_L(8); PG8_BAR; PG8_WAIT_L(0); PG8_MMA(0, 0, At, B0); PG8_BAR; PG8_SCHED;
            PG8_LDB(B1, 0, 1); PG8_STAGE(PG8_SB(0, 0), b2, voffB);
            PG8_BAR; PG8_WAIT_L(0); PG8_MMA(0, 1, At, B1); PG8_BAR;
            PG8_LDA(At, 0, 1); PG8_STAGE(PG8_SA(0, 0), a2, voffA);
            PG8_BAR; PG8_WAIT_L(0); PG8_MMA(1, 0, At, B0); PG8_BAR; PG8_SCHED;
            PG8_STAGE(PG8_SB(0, 1), b2 + hstep, voffB);
            PG8_WAIT_V(6); PG8_BAR; PG8_MMA(1, 1, At, B1); PG8_BAR;
            PG8_LDB(B0, 1, 0); PG8_SCHED; PG8_LDA(At, 1, 0); PG8_STAGE(PG8_SA(0, 1), a2 + hstep, voffA);
            PG8_WAIT_L(8); PG8_BAR; PG8_WAIT_L(0); PG8_MMA(0, 0, At, B0); PG8_BAR; PG8_SCHED;
            PG8_LDB(B1, 1, 1); PG8_STAGE(PG8_SB(1, 0), b3, voffB);
            PG8_BAR; PG8_WAIT_L(0); PG8_MMA(0, 1, At, B1); PG8_BAR;
            PG8_LDA(At, 1, 1); PG8_STAGE(PG8_SA(1, 0), a3, voffA);
            PG8_BAR; PG8_WAIT_L(0); PG8_MMA(1, 0, At, B0); PG8_BAR; PG8_SCHED;
            PG8_STAGE(PG8_SB(1, 1), b3 + hstep, voffB);
            PG8_WAIT_V(6); PG8_BAR; PG8_MMA(1, 1, At, B1); PG8_BAR;
            }
        }
        if constexpr (F8) asm volatile("s_nop 15\n\ts_nop 15" ::: "memory");
        if constexpr (ALIGN_EPI) { if (wr == 0) PG8_BAR; }
        if constexpr (!Epi::AFTER_DRAIN) {
            if constexpr (Epi::PREF) E(acc, cur, wr, wc, fr, fq, (const PG8_LAS float*)(lds + RS_SLOT + (ui & 1) * 1024)); else E(acc, cur, wr, wc, fr, fq);
            S.done(cur); }
        if (!has_next) break;
#pragma unroll
        for (int a = 0; a < 2; ++a)
#pragma unroll
            for (int b = 0; b < 2; ++b)
#pragma unroll
                for (int m = 0; m < 4; ++m)
#pragma unroll
                    for (int n = 0; n < 2; ++n) acc[a][b][m][n] = (f32x4){0.f, 0.f, 0.f, 0.f};
        cur = nxt; cA = nA; cB = nB; ++ui;
        if constexpr (ALIGN_EPI) { if (wr == 1) PG8_BAR; }
    }
    PG8_WAIT_V(0);
    if constexpr (!ALIGN_EPI) { if (wr == 0) PG8_BAR; }
    PG8_BAR;
    if constexpr (Epi::AFTER_DRAIN) { E.fused(acc, cur, wr, wc, fr, fq, lds, wid, lane); S.done(cur); }
#undef PG8_RSDMA
#undef PG8_SA
#undef PG8_SB
#undef PG8_STAGE
#undef PG8_LDA
#undef PG8_LDB
#undef PG8_MMA
#undef PG8_WAIT_V
#undef PG8_WAIT_L
#undef PG8_BAR
#undef PG8_SCHED
}
}
constexpr int NWAVES = 8;
constexpr int DM = 2048, DFF = 5504, NPROMPT = 4 * 8192, NSAMPLE = 32 * 64, MTOK = NPROMPT + NSAMPLE;
constexpr int INCOLS = 10240, WQA = 1024;
constexpr float EPS = 1e-6f;
constexpr int N_UNITS = 2560;
constexpr size_t MiB = 1u << 20;
constexpr size_t WS_CTL = 0, CTL_ZERO_BYTES = 1 * MiB;
constexpr size_t WS_LAM = 1 * MiB;
constexpr size_t WS_RSTD = 1 * MiB + 4096;
constexpr size_t WS_WIN = 2 * MiB;
constexpr size_t WS_F1GU = WS_WIN + (size_t)INCOLS * DM * 2;
constexpr size_t WS_F1D = WS_F1GU + (size_t)2 * DFF * DM * 2;
constexpr size_t WS_F2GU = WS_F1D + (size_t)DM * DFF * 2;
constexpr size_t WS_F2D = WS_F2GU + (size_t)2 * DFF * DM * 2;
constexpr size_t WS_WAB = WS_F2D + (size_t)DM * DFF * 2;
constexpr size_t WS_WO = WS_WAB + (size_t)4096 * 1024 * 2;
constexpr size_t WS_XN = WS_WO + (size_t)DM * DM * 2;
constexpr size_t WS_D = WS_XN + (size_t)MTOK * DM * 2;
constexpr size_t WS_BIG = WS_D + (size_t)MTOK * DM * 2;
constexpr size_t SZ_HEAD = (size_t)MTOK * 1024 * 2;
constexpr size_t WS_QA = WS_BIG, WS_QB = WS_QA + SZ_HEAD, WS_KA = WS_QB + SZ_HEAD, WS_VA = WS_KA + SZ_HEAD, WS_KB = WS_VA + SZ_HEAD, WS_VB = WS_KB + SZ_HEAD;
constexpr size_t WS_SGA = WS_VB + SZ_HEAD, WS_SGB = WS_SGA + 2 * SZ_HEAD, WS_END = WS_SGB + 2 * SZ_HEAD;
static_assert(WS_BIG + (size_t)MTOK * DFF * 2 <= WS_END, "ACT fits the big region");
static_assert((size_t)256 * 2 * 1088 * 128 * 2 <= (size_t)MTOK * DM * 2 && WS_RSTD + (size_t)MTOK * 4 <= WS_WIN, "the sample units' key/value copies and MERGED fit the (still unused) y region of d_out");
constexpr int CW_TMO = 0, CW_QUEUE = 64, CW_BAR = 4096;

constexpr int RING_OFF = 0, RING_BYTES = 131072;
constexpr int LDSCTL_OFF = RING_BYTES, MISC_OFF = LDSCTL_OFF + 320;
constexpr int LDS_BYTES = 147456;

struct Inputs {
    const float *x_prompt, *x_sample, *cdk, *cdv, *csk, *csv, *w_in, *w_up_a, *w_up_b, *w_o, *lq1, *lk1, *lq2, *lk2, *subln_g;
    const float *n1a, *n1b, *nma, *nmb, *n2a, *n2b, *f1g, *f1u, *f1d, *f2g, *f2u, *f2d;
};
struct Args { Inputs in; float* out; unsigned char* ws; };
typedef const __attribute__((address_space(4))) Args* KArgs;
namespace att {
typedef unsigned short bf16;
using bf16x8 = __attribute__((ext_vector_type(8))) short;
using s16x4  = __attribute__((ext_vector_type(4))) short;
using f32x16 = __attribute__((ext_vector_type(16))) float;
using f32x8  = __attribute__((ext_vector_type(8))) float;
using f32x4  = __attribute__((ext_vector_type(4))) float;
using u32x4  = __attribute__((ext_vector_type(4))) unsigned;
constexpr int NW = 8, QBLK = 32, KVBLK = 64, LD = 1024;
constexpr size_t SHM_V = KVBLK * 128 * 2, SHM_K = KVBLK * 128 * 2, SHM_ATTN = 2 * SHM_V + 2 * SHM_K + NW * 8192;
constexpr size_t OFF_Q = 65536, OFF_WS = 131072 + 1024, OFF_VOTE = OFF_WS + NW * 64 * 4, OFF_DMA = OFF_VOTE + 64;
constexpr float THR2 = 11.0f;
#define KSWZ(row, colB) ((row) * 256 + ((colB) ^ (((row) & 7) << 4)))
#define SBAR() __builtin_amdgcn_sched_barrier(0)
__device__ __forceinline__ int crow(int r, int hi) { return (r & 3) + 8 * (r >> 2) + 4 * hi; }
__device__ __forceinline__ unsigned cvtpk(float lo, float hi) { return pg8::cvt_pk_bf16(lo, hi); }
template <typename TIn> struct Stage;
template <> struct Stage<bf16>  { using T = bf16x8;
  __device__ static __forceinline__ T ld8(const bf16* p) { return *reinterpret_cast<const bf16x8*>(p); }
  __device__ static __forceinline__ bf16x8 tobf(T x) { return x; } };
template <> struct Stage<float> { using T = bf16x8;
  __device__ static __forceinline__ T ld8(const float* p) { const f32x8 x = *reinterpret_cast<const f32x8*>(p);
    u32x4 w = {cvtpk(x[0], x[1]), cvtpk(x[2], x[3]), cvtpk(x[4], x[5]), cvtpk(x[6], x[7])}; return *reinterpret_cast<bf16x8*>(&w); }
  __device__ static __forceinline__ bf16x8 tobf(T x) { return x; } };
struct KVLin { typedef bf16 T; static constexpr int PITCH = LD; const bf16* k0; const bf16* v0;
  __device__ __forceinline__ const bf16* krow(int k) const { return k0 + (size_t)k * LD; }
  __device__ __forceinline__ const bf16* vrow(int k) const { return v0 + (size_t)k * LD; } };
struct KVScr { typedef bf16 T; static constexpr int PITCH = 128; const bf16* k0; const bf16* v0;
  __device__ __forceinline__ const bf16* krow(int k) const { return k0 + (size_t)k * 128; }
  __device__ __forceinline__ const bf16* vrow(int k) const { return v0 + (size_t)k * 128; } };
struct KVTwo { typedef float T; const float* k0; const float* v0; const float* k1; const float* v1; int n0;
  __device__ __forceinline__ const float* krow(int k) const { return k < n0 ? k0 + (size_t)k * LD : k1 + (size_t)((k - n0) & 63) * LD; }
  __device__ __forceinline__ const float* vrow(int k) const { return k < n0 ? v0 + (size_t)k * LD : v1 + (size_t)((k - n0) & 63) * LD; } };

#define PK4(P, BASE, OUT) do { u32x4 w = {cvtpk(P[BASE + 0], P[BASE + 1]), cvtpk(P[BASE + 2], P[BASE + 3]), cvtpk(P[BASE + 4], P[BASE + 5]), cvtpk(P[BASE + 6], P[BASE + 7])}; \
    OUT = __builtin_bit_cast(bf16x8, w); } while (0)

__device__ __forceinline__ void partialSM(f32x16& p0, f32x16& p1, float& m_reg, float& alpha) {
  float pmax;
  { float a = __builtin_fmaxf(__builtin_fmaxf(p0[0], p0[1]), p0[2]), b = __builtin_fmaxf(__builtin_fmaxf(p0[3], p0[4]), p0[5]), c = __builtin_fmaxf(__builtin_fmaxf(p1[0], p1[1]), p1[2]), d = __builtin_fmaxf(__builtin_fmaxf(p1[3], p1[4]), p1[5]);
    a = __builtin_fmaxf(__builtin_fmaxf(a, p0[6]), p0[7]); b = __builtin_fmaxf(__builtin_fmaxf(b, p0[8]), p0[9]); c = __builtin_fmaxf(__builtin_fmaxf(c, p1[6]), p1[7]); d = __builtin_fmaxf(__builtin_fmaxf(d, p1[8]), p1[9]);
    a = __builtin_fmaxf(__builtin_fmaxf(a, p0[10]), p0[11]); b = __builtin_fmaxf(__builtin_fmaxf(b, p0[12]), p0[13]); c = __builtin_fmaxf(__builtin_fmaxf(c, p1[10]), p1[11]); d = __builtin_fmaxf(__builtin_fmaxf(d, p1[12]), p1[13]);
    a = __builtin_fmaxf(__builtin_fmaxf(a, p0[14]), p0[15]); c = __builtin_fmaxf(__builtin_fmaxf(c, p1[14]), p1[15]);
    pmax = __builtin_fmaxf(__builtin_fmaxf(a, b), __builtin_fmaxf(c, d)); }
  { auto rr = __builtin_amdgcn_permlane32_swap(__float_as_uint(pmax), __float_as_uint(pmax), false, false);
    pmax = fmaxf(__uint_as_float(rr[0]), __uint_as_float(rr[1])); }
  float mn;
  if (__builtin_expect(__all(pmax - m_reg <= THR2), 1)) { mn = m_reg; alpha = 1.f; }
  else { mn = fmaxf(m_reg, pmax); alpha = __builtin_amdgcn_exp2f(m_reg - mn); m_reg = mn; }
#pragma unroll
  for (int r = 0; r < 16; ++r) p0[r] = p0[r] - mn;
#pragma unroll
  for (int r = 0; r < 16; ++r) p1[r] = p1[r] - mn;
#pragma unroll
  for (int r = 0; r < 16; ++r) p0[r] = __builtin_amdgcn_exp2f(p0[r]);
}
__device__ __forceinline__ void finishSM(f32x16& p0, f32x16& p1, float alpha, float& l_reg, bf16x8& pa0, bf16x8& pa1, bf16x8& pa2, bf16x8& pa3) {
#pragma unroll
  for (int r = 0; r < 16; ++r) p1[r] = __builtin_amdgcn_exp2f(p1[r]);
  float ps;
  { float a = p0[0] + p0[1], b = p0[2] + p0[3], c = p1[0] + p1[1], d = p1[2] + p1[3];
#pragma unroll
    for (int r = 4; r < 16; r += 4) { a += p0[r]; a += p0[r + 1]; b += p0[r + 2]; b += p0[r + 3]; c += p1[r]; c += p1[r + 1]; d += p1[r + 2]; d += p1[r + 3]; }
    ps = (a + b) + (c + d); }
  { auto rr = __builtin_amdgcn_permlane32_swap(__float_as_uint(ps), __float_as_uint(ps), false, false);
    ps = __uint_as_float(rr[0]) + __uint_as_float(rr[1]); }
  l_reg = l_reg * alpha + ps;
  PK4(p0, 0, pa0); PK4(p0, 8, pa1); PK4(p1, 0, pa2); PK4(p1, 8, pa3);
}
__device__ __forceinline__ float rowsum32(const f32x16& p0, const f32x16& p1) {
  float a = p0[0] + p0[1], b = p0[2] + p0[3], c = p1[0] + p1[1], d = p1[2] + p1[3];
#pragma unroll
  for (int r = 4; r < 16; r += 4) { a += p0[r]; a += p0[r + 1]; b += p0[r + 2]; b += p0[r + 3]; c += p1[r]; c += p1[r + 1]; d += p1[r + 2]; d += p1[r + 3]; }
  const float ps = (a + b) + (c + d);
  auto rr = __builtin_amdgcn_permlane32_swap(__float_as_uint(ps), __float_as_uint(ps), false, false);
  return __uint_as_float(rr[0]) + __uint_as_float(rr[1]);
}
__device__ __forceinline__ float rowmax32(const f32x16& p0, const f32x16& p1) {
  float a = __builtin_fmaxf(__builtin_fmaxf(p0[0], p0[1]), p0[2]), b = __builtin_fmaxf(__builtin_fmaxf(p0[3], p0[4]), p0[5]), c = __builtin_fmaxf(__builtin_fmaxf(p1[0], p1[1]), p1[2]), d = __builtin_fmaxf(__builtin_fmaxf(p1[3], p1[4]), p1[5]);
  a = __builtin_fmaxf(__builtin_fmaxf(a, p0[6]), p0[7]); b = __builtin_fmaxf(__builtin_fmaxf(b, p0[8]), p0[9]); c = __builtin_fmaxf(__builtin_fmaxf(c, p1[6]), p1[7]); d = __builtin_fmaxf(__builtin_fmaxf(d, p1[8]), p1[9]);
  a = __builtin_fmaxf(__builtin_fmaxf(a, p0[10]), p0[11]); b = __builtin_fmaxf(__builtin_fmaxf(b, p0[12]), p0[13]); c = __builtin_fmaxf(__builtin_fmaxf(c, p1[10]), p1[11]); d = __builtin_fmaxf(__builtin_fmaxf(d, p1[12]), p1[13]);
  a = __builtin_fmaxf(__builtin_fmaxf(a, p0[14]), p0[15]); c = __builtin_fmaxf(__builtin_fmaxf(c, p1[14]), p1[15]);
  const float m = __builtin_fmaxf(__builtin_fmaxf(a, b), __builtin_fmaxf(c, d));
  auto rr = __builtin_amdgcn_permlane32_swap(__float_as_uint(m), __float_as_uint(m), false, false);
  return __builtin_fmaxf(__uint_as_float(rr[0]), __uint_as_float(rr[1]));
}
#define SBGRP(P, B, kb, T) do { float z_[4], s_[4];                                                                          \
    _Pragma("unroll") for (int k_ = 0; k_ < 4; ++k_) { const float zz = P[(B) + k_];                                           \
      const float e_ = __builtin_amdgcn_exp2f(-__builtin_fabsf(zz)); const float l_ = __builtin_amdgcn_logf(1.0f + e_);        \
      float u_ = -(fmaxf(zz, 0.f) + l_); float zk = zz;                                                                         \
      if (needmask) { const bool msk_ = (kbase + (kb) + k_) >= qrow; u_ = msk_ ? 0.f : u_; zk = msk_ ? -INFINITY : zk; }        \
      z_[k_] = zk; s_[k_] = u_; }                                                                                               \
    s_[2] += s_[3]; s_[1] += s_[2]; s_[0] += s_[1]; T = s_[0];                                                                 \
    _Pragma("unroll") for (int k_ = 0; k_ < 4; ++k_) P[(B) + k_] = z_[k_] + s_[k_]; } while (0)
__device__ __forceinline__ void partialSB(f32x16& p0, f32x16& p1, float& R, int kbase, int qrow, bool needmask, int hi) {
  float T0[4], T1[4];
  const int h4 = 4 * hi;
  SBGRP(p1, 12, 32 + 24 + h4, T1[3]); SBGRP(p1, 8, 32 + 16 + h4, T1[2]); SBGRP(p1, 4, 32 + 8 + h4, T1[1]); SBGRP(p1, 0, 32 + h4, T1[0]);
  SBGRP(p0, 12, 24 + h4, T0[3]); SBGRP(p0, 8, 16 + h4, T0[2]); SBGRP(p0, 4, 8 + h4, T0[1]); SBGRP(p0, 0, h4, T0[0]);
  float off0[4], off1[4]; float X = R;
  const float selh = hi ? 0.f : 1.f;
#pragma unroll
  for (int g = 3; g >= 0; --g) { auto rr = __builtin_amdgcn_permlane32_swap(__float_as_uint(T1[g]), __float_as_uint(T1[g]), false, false);
    const float TL = __uint_as_float(rr[0]), TH = __uint_as_float(rr[1]); off1[g] = X + selh * TH; X = X + (TL + TH); }
#pragma unroll
  for (int g = 3; g >= 0; --g) { auto rr = __builtin_amdgcn_permlane32_swap(__float_as_uint(T0[g]), __float_as_uint(T0[g]), false, false);
    const float TL = __uint_as_float(rr[0]), TH = __uint_as_float(rr[1]); off0[g] = X + selh * TH; X = X + (TL + TH); }
  R = X;
#pragma unroll
  for (int r = 0; r < 16; ++r) { p1[r] += off1[r >> 2]; p0[r] += off0[r >> 2]; }
}
__device__ __forceinline__ void finishSB(f32x16& p0, f32x16& p1, bf16x8& pa0, bf16x8& pa1, bf16x8& pa2, bf16x8& pa3) {
#pragma unroll
  for (int r = 0; r < 16; ++r) p0[r] = __builtin_amdgcn_exp2f(p0[r]);
#pragma unroll
  for (int r = 0; r < 16; ++r) p1[r] = __builtin_amdgcn_exp2f(p1[r]);
  PK4(p0, 0, pa0); PK4(p0, 8, pa1); PK4(p1, 0, pa2); PK4(p1, 8, pa3);
}
template <int NQ>
__device__ __forceinline__ void qkt(f32x16& p0, f32x16& p1, const char* Ks, const bf16x8* qr, int r32, int hi, int kcolB) {
  p0 = f32x16{}; p1 = f32x16{};
#pragma unroll
  for (int d0 = 0; d0 < NQ; ++d0) { const int cb = kcolB + (d0 * 16 + hi * 8) * 2;
    bf16x8 b0 = *reinterpret_cast<const bf16x8*>(Ks + KSWZ(r32, cb));
    bf16x8 b1 = *reinterpret_cast<const bf16x8*>(Ks + KSWZ(32 + r32, cb));
    p0 = __builtin_amdgcn_mfma_f32_32x32x16_bf16(b0, qr[d0], p0, 0, 0, 0);
    p1 = __builtin_amdgcn_mfma_f32_32x32x16_bf16(b1, qr[d0], p1, 0, 0, 0); }
}
__device__ __forceinline__ void qkt_q(f32x16& p0, f32x16& p1, const char* Ks, const char* Qs, int r32, int hi, int kcolB) {
  p0 = f32x16{}; p1 = f32x16{};
#pragma unroll
  for (int d0 = 0; d0 < 4; ++d0) { const int cb = kcolB + (d0 * 16 + hi * 8) * 2;
    const bf16x8 q = *reinterpret_cast<const bf16x8*>(Qs + d0 * 1024);
    const bf16x8 b0 = *reinterpret_cast<const bf16x8*>(Ks + KSWZ(r32, cb));
    const bf16x8 b1 = *reinterpret_cast<const bf16x8*>(Ks + KSWZ(32 + r32, cb));
    p0 = __builtin_amdgcn_mfma_f32_32x32x16_bf16(b0, q, p0, 0, 0, 0);
    p1 = __builtin_amdgcn_mfma_f32_32x32x16_bf16(b1, q, p1, 0, 0, 0);
    if (d0 == 1) asm volatile("" ::: "memory"); }
}
template <int OFF> __device__ __forceinline__ bf16x8 lds_rd128(int a) { bf16x8 r; asm volatile("ds_read_b128 %0, %1 offset:%2" : "=&v"(r) : "v"(a), "i"(OFF) : "memory"); return r; }
template <int KOFF, int QB>
__device__ __forceinline__ void qkt_pipe(f32x16& p0, f32x16& p1, const int (&ka)[4], int qa) {
  bf16x8 q[3], k0[3], k1[3];
  q[0] = lds_rd128<QB>(qa);        k0[0] = lds_rd128<KOFF>(ka[0]); k1[0] = lds_rd128<KOFF + 8192>(ka[0]);
  q[1] = lds_rd128<QB + 1024>(qa); k0[1] = lds_rd128<KOFF>(ka[1]); k1[1] = lds_rd128<KOFF + 8192>(ka[1]);
  q[2] = lds_rd128<QB + 2048>(qa); k0[2] = lds_rd128<KOFF>(ka[2]); k1[2] = lds_rd128<KOFF + 8192>(ka[2]);
  asm volatile("s_waitcnt lgkmcnt(6)" ::: "memory"); SBAR();
  p0 = __builtin_amdgcn_mfma_f32_32x32x16_bf16(k0[0], q[0], f32x16{}, 0, 0, 0); p1 = __builtin_amdgcn_mfma_f32_32x32x16_bf16(k1[0], q[0], f32x16{}, 0, 0, 0); SBAR();
  q[0] = lds_rd128<QB + 3072>(qa); k0[0] = lds_rd128<KOFF>(ka[3]); k1[0] = lds_rd128<KOFF + 8192>(ka[3]);
  asm volatile("s_waitcnt lgkmcnt(6)" ::: "memory"); SBAR();
  p0 = __builtin_amdgcn_mfma_f32_32x32x16_bf16(k0[1], q[1], p0, 0, 0, 0); p1 = __builtin_amdgcn_mfma_f32_32x32x16_bf16(k1[1], q[1], p1, 0, 0, 0); SBAR();
  asm volatile("s_waitcnt lgkmcnt(3)" ::: "memory"); SBAR();
  p0 = __builtin_amdgcn_mfma_f32_32x32x16_bf16(k0[2], q[2], p0, 0, 0, 0); p1 = __builtin_amdgcn_mfma_f32_32x32x16_bf16(k1[2], q[2], p1, 0, 0, 0); SBAR();
  asm volatile("s_waitcnt lgkmcnt(0)" ::: "memory"); SBAR();
  p0 = __builtin_amdgcn_mfma_f32_32x32x16_bf16(k0[0], q[0], p0, 0, 0, 0); p1 = __builtin_amdgcn_mfma_f32_32x32x16_bf16(k1[0], q[0], p1, 0, 0, 0); SBAR();
}
__device__ __forceinline__ int v_st(int k, int c) { const int kk = (k & ~0xC) | ((k & 4) << 1) | ((k & 8) >> 1); return ((kk >> 3) * 4 + (c >> 5)) * 512 + ((kk & 7) * 32 + (c & 31)) * 2; }
__device__ __forceinline__ int v_rd_base(int lane) { return ((lane & 3) << 3) | (((lane >> 2) & 3) << 6) | (((lane >> 4) & 1) << 5) | (((lane >> 5) & 1) << 11); }
constexpr int v_rd_off(int d0, int ks, int half) { return d0 * 512 + ks * 4096 + half * 256; }
template <int OFF> __device__ __forceinline__ s16x4 tr_read(int vb) {
  s16x4 r; asm volatile("ds_read_b64_tr_b16 %0, %1 offset:%2" : "=&v"(r) : "v"(vb), "i"(OFF) : "memory"); return r;
}
template <int D0> __device__ __forceinline__ void pv_one(f32x16& od, int vb, bf16x8 pa0, bf16x8 pa1, bf16x8 pa2, bf16x8 pa3) {
  const s16x4 l0 = tr_read<v_rd_off(D0, 0, 0)>(vb), h0 = tr_read<v_rd_off(D0, 0, 1)>(vb), l1 = tr_read<v_rd_off(D0, 1, 0)>(vb), h1 = tr_read<v_rd_off(D0, 1, 1)>(vb);
  const s16x4 l2 = tr_read<v_rd_off(D0, 2, 0)>(vb), h2 = tr_read<v_rd_off(D0, 2, 1)>(vb), l3 = tr_read<v_rd_off(D0, 3, 0)>(vb), h3 = tr_read<v_rd_off(D0, 3, 1)>(vb);
  asm volatile("s_waitcnt lgkmcnt(0)" ::: "memory"); SBAR();
#define PKV(L, H) (bf16x8){L[0], L[1], L[2], L[3], H[0], H[1], H[2], H[3]}
  od = __builtin_amdgcn_mfma_f32_32x32x16_bf16(pa0, PKV(l0, h0), od, 0, 0, 0);
  od = __builtin_amdgcn_mfma_f32_32x32x16_bf16(pa1, PKV(l1, h1), od, 0, 0, 0);
  od = __builtin_amdgcn_mfma_f32_32x32x16_bf16(pa2, PKV(l2, h2), od, 0, 0, 0);
  od = __builtin_amdgcn_mfma_f32_32x32x16_bf16(pa3, PKV(l3, h3), od, 0, 0, 0);
#undef PKV
}
__device__ __forceinline__ void pv_d0(f32x16* o, int vb, bf16x8 pa0, bf16x8 pa1, bf16x8 pa2, bf16x8 pa3) {
  pv_one<0>(o[0], vb, pa0, pa1, pa2, pa3); pv_one<1>(o[1], vb, pa0, pa1, pa2, pa3); pv_one<2>(o[2], vb, pa0, pa1, pa2, pa3); pv_one<3>(o[3], vb, pa0, pa1, pa2, pa3);
}

struct VFrag { s16x4 l[4], h[4]; };
template <int KS> __device__ __forceinline__ void tr_group(VFrag& f, int vb) {
  f.l[0] = tr_read<v_rd_off(0, KS, 0)>(vb); f.h[0] = tr_read<v_rd_off(0, KS, 1)>(vb); f.l[1] = tr_read<v_rd_off(1, KS, 0)>(vb); f.h[1] = tr_read<v_rd_off(1, KS, 1)>(vb);
  f.l[2] = tr_read<v_rd_off(2, KS, 0)>(vb); f.h[2] = tr_read<v_rd_off(2, KS, 1)>(vb); f.l[3] = tr_read<v_rd_off(3, KS, 0)>(vb); f.h[3] = tr_read<v_rd_off(3, KS, 1)>(vb);
}
__device__ __forceinline__ void mma_group2(f32x16* oa, f32x16* ob, const VFrag& f, bf16x8 pa, bf16x8 pb) {
#define PKV(L, H) (bf16x8){L[0], L[1], L[2], L[3], H[0], H[1], H[2], H[3]}
  const bf16x8 v0 = PKV(f.l[0], f.h[0]), v1 = PKV(f.l[1], f.h[1]), v2 = PKV(f.l[2], f.h[2]), v3 = PKV(f.l[3], f.h[3]);
  asm volatile("v_mfma_f32_32x32x16_bf16 %0, %4, %5, %0\n\tv_mfma_f32_32x32x16_bf16 %1, %4, %6, %1\n\tv_mfma_f32_32x32x16_bf16 %2, %4, %7, %2\n\tv_mfma_f32_32x32x16_bf16 %3, %4, %8, %3"
               : "+v"(oa[0]), "+v"(oa[1]), "+v"(oa[2]), "+v"(oa[3]) : "v"(pa), "v"(v0), "v"(v1), "v"(v2), "v"(v3));
  asm volatile("v_mfma_f32_32x32x16_bf16 %0, %4, %5, %0\n\tv_mfma_f32_32x32x16_bf16 %1, %4, %6, %1\n\tv_mfma_f32_32x32x16_bf16 %2, %4, %7, %2\n\tv_mfma_f32_32x32x16_bf16 %3, %4, %8, %3"
               : "+v"(ob[0]), "+v"(ob[1]), "+v"(ob[2]), "+v"(ob[3]) : "v"(pb), "v"(v0), "v"(v1), "v"(v2), "v"(v3));
#undef PKV
}
__device__ __forceinline__ void pv_shared(f32x16* oa, f32x16* ob, int vb, const bf16x8 (&pa)[4], const bf16x8 (&pb)[4]) {
  VFrag fa, fb;
  tr_group<0>(fa, vb); tr_group<1>(fb, vb);
  asm volatile("s_waitcnt lgkmcnt(8)" ::: "memory"); SBAR(); mma_group2(oa, ob, fa, pa[0], pb[0]); SBAR();
  tr_group<2>(fa, vb);
  asm volatile("s_waitcnt lgkmcnt(8)" ::: "memory"); SBAR(); mma_group2(oa, ob, fb, pa[1], pb[1]); SBAR();
  tr_group<3>(fb, vb);
  asm volatile("s_waitcnt lgkmcnt(8)" ::: "memory"); SBAR(); mma_group2(oa, ob, fa, pa[2], pb[2]); SBAR();
  asm volatile("s_waitcnt lgkmcnt(0)" ::: "memory"); SBAR(); mma_group2(oa, ob, fb, pa[3], pb[3]); SBAR();
}

constexpr float SB_DEAD = -152.0f;
template <int MODE, typename SRC, bool EARLY>
__device__ __forceinline__ void attn_pass_simple(const bf16* __restrict__ Qw, const SRC& src, int NT, int nvis, int qrow, int kcolB, f32x16 (&o)[4], float& l_out, char* lds, bool active = true) {
  using St = Stage<typename SRC::T>;
  constexpr int NQ = MODE == 0 ? 4 : 8;
  int tid = tidx(); asm volatile("" : "+v"(tid));
  const int wid = __builtin_amdgcn_readfirstlane(tid >> 6), lane = tid & 63, r32 = lane & 31, hi = lane >> 5;
  char* V_lds = lds; char* K_lds = lds + 2 * SHM_V;
  float* ws = (float*)(lds + OFF_WS) + wid * 64; float* al_l = ws + 32;
  volatile PG8_LAS unsigned* vote = (volatile PG8_LAS unsigned*)(uintptr_t)(unsigned)(uintptr_t)(lds + OFF_VOTE);
  float m_reg = -1e30f, l_reg = 0.f, Rsb = 0.f; bf16x8 qr[NQ]; bool wdead = !active;
#pragma unroll
  for (int d0 = 0; d0 < 4; ++d0) o[d0] = f32x16{};
#pragma unroll
  for (int d0 = 0; d0 < NQ; ++d0) qr[d0] = *reinterpret_cast<const bf16x8*>(Qw + d0 * 16);
  const int sr = tid >> 4, sc = (tid & 15) * 8, vst0 = v_st(sr, sc), vst1 = v_st(32 + sr, sc);
  const int vb0 = (int)(uintptr_t)V_lds + v_rd_base(lane);
  const int qrow0 = __builtin_amdgcn_readfirstlane(qrow - r32);
  typename St::T vs0, vs1, ks0, ks1;
#define TT(s) (MODE == 1 ? (NT - 1 - (s)) : (s))
#define SLOAD1(s) do { const int ka_ = TT(s) * KVBLK + sr; vs0 = St::ld8(src.vrow(ka_) + sc); vs1 = St::ld8(src.vrow(ka_ + 32) + sc); ks0 = St::ld8(src.krow(ka_) + sc); ks1 = St::ld8(src.krow(ka_ + 32) + sc); } while (0)
#define SWRITE1(b) do { *(bf16x8*)(V_lds + (b) * SHM_V + vst0) = St::tobf(vs0); *(bf16x8*)(V_lds + (b) * SHM_V + vst1) = St::tobf(vs1); const int kc = sc * 2; \
    *(bf16x8*)(K_lds + (b) * SHM_K + KSWZ(sr, kc)) = St::tobf(ks0); *(bf16x8*)(K_lds + (b) * SHM_K + KSWZ(32 + sr, kc)) = St::tobf(ks1); } while (0)
  SLOAD1(0); asm volatile("s_waitcnt vmcnt(0)" ::: "memory"); SWRITE1(0); __syncthreads();
  for (int s = 0; s < NT; ++s) {
    const int b = s & 1; const bool more = s + 1 < NT;
    if (more) SLOAD1(s + 1);
    const bool work = MODE == 0 ? true : (active && !wdead && (TT(s) * KVBLK < qrow0 + 31));
    if (work) {
    f32x16 p0, p1; bf16x8 pa0, pa1, pa2, pa3;
    SBAR(); qkt<NQ>(p0, p1, K_lds + b * SHM_K, qr, r32, hi, kcolB);
    if (MODE == 0) {
      if (TT(s) >= nvis) {
#pragma unroll
        for (int r = 0; r < 16; ++r) { p0[r] = -1e30f; p1[r] = -1e30f; } }
      float al; partialSM(p0, p1, m_reg, al);
      if (__any(al < 1.f)) { if (hi == 0) al_l[r32] = al; asm volatile("s_waitcnt lgkmcnt(0)" ::: "memory");
#pragma unroll
        for (int d = 0; d < 4; ++d)
#pragma unroll
          for (int r = 0; r < 16; ++r) o[d][r] *= al_l[crow(r, hi)]; }
      finishSM(p0, p1, al, l_reg, pa0, pa1, pa2, pa3);
    } else {
      const int kb_ = TT(s) * KVBLK; partialSB(p0, p1, Rsb, kb_, qrow, (kb_ + KVBLK > qrow0), hi);
      finishSB(p0, p1, pa0, pa1, pa2, pa3);
    }
    SBAR(); pv_d0(o, vb0 + b * (int)SHM_V, pa0, pa1, pa2, pa3);
    }
    if (more) SWRITE1(b ^ 1);
    if (MODE == 1) wdead = !active || __all(Rsb < SB_DEAD);
    if (EARLY) { if (lane == 0) vote[b * 8 + wid] = wdead ? 1u : 0u; }
    __syncthreads();
    if (EARLY) { unsigned all = 1u;
#pragma unroll
      for (int w = 0; w < NW; ++w) all &= vote[b * 8 + w];
      if (all) break; }
  }
  l_out = l_reg;
  __syncthreads();
#undef TT
#undef SLOAD1
#undef SWRITE1
}

#define LBAR() do { asm volatile("s_waitcnt lgkmcnt(0)" ::: "memory"); __builtin_amdgcn_s_barrier(); asm volatile("" ::: "memory"); } while (0)
template <typename SRC>
__device__ __forceinline__ void attn_diff_pass(const bf16* __restrict__ Qw, const SRC& src, int NT, int nvis, f32x16 (&o1)[4], f32x16 (&o2)[4], float& l1_out, float& l2_out, char* lds) {
  int tid = tidx(); asm volatile("" : "+v"(tid));
  const int wid = __builtin_amdgcn_readfirstlane(tid >> 6), lane = tid & 63, r32 = lane & 31, hi = lane >> 5;
  char* V_lds = lds; char* K_lds = lds + 2 * SHM_V;
  float m1 = 0.f, l1 = 0.f, m2 = 0.f, l2 = 0.f;
#pragma unroll
  for (int d0 = 0; d0 < 4; ++d0) { o1[d0] = f32x16{}; o2[d0] = f32x16{}; }
  char* Qs = lds + OFF_Q + wid * 8192 + lane * 16;
  const int qsa = (int)(uintptr_t)Qs;
  bf16x8 qtmp[8];
#pragma unroll
  for (int d0 = 0; d0 < 8; ++d0) qtmp[d0] = *reinterpret_cast<const bf16x8*>(Qw + d0 * 16);
  const int vb0 = (int)(uintptr_t)V_lds + v_rd_base(lane);
  const int kad0 = (int)(uintptr_t)K_lds + KSWZ(r32, hi * 16);
  typedef int i32x4_ __attribute__((ext_vector_type(4)));
  const int dslot_delta = (int)OFF_DMA - (int)OFF_Q + wid * (1024 - 8192);
#define DSLOT() ((PG8_LAS i32x4_*)(uintptr_t)(unsigned)(qsa + dslot_delta))
  { int ko_[2], vo_[2];
#pragma unroll
    for (int i = 0; i < 2; ++i) { const int g = (2 * wid + i) * 64 + lane;
      ko_[i] = (g >> 4) * SRC::PITCH + ((g & 15) ^ ((g >> 4) & 7)) * 8;
      const int blk = g >> 5, kk = (blk >> 2) * 8 + ((g & 31) >> 2); vo_[i] = ((kk & ~0xC) | ((kk & 4) << 1) | ((kk & 8) >> 1)) * SRC::PITCH + (blk & 3) * 32 + (g & 3) * 8; }
    *DSLOT() = (i32x4_){2 * ko_[0], 2 * ko_[1], 2 * vo_[0], 2 * vo_[1]}; }
  const unsigned ldsK = (unsigned)(uintptr_t)K_lds + (unsigned)wid * 2048u, ldsV = (unsigned)(uintptr_t)V_lds + (unsigned)wid * 2048u;
#define KVDMA1(OFF_, BASE_, LDS_) asm volatile("s_mov_b32 m0, %2\n\ts_nop 0\n\tglobal_load_lds_dwordx4 %0, %1" :: "v"(OFF_), "s"((const char*)(BASE_)), "s"((unsigned)(LDS_)) : "memory")
#define KVDMA(s, B_) do { const i32x4_ of_ = *(volatile PG8_LAS i32x4_*)DSLOT(); \
      KVDMA1(of_.x, src.krow((s) * KVBLK), ldsK + (unsigned)((B_) * (int)SHM_K)); KVDMA1(of_.y, src.krow((s) * KVBLK), ldsK + (unsigned)((B_) * (int)SHM_K + 1024)); \
      KVDMA1(of_.z, src.vrow((s) * KVBLK), ldsV + (unsigned)((B_) * (int)SHM_V)); KVDMA1(of_.w, src.vrow((s) * KVBLK), ldsV + (unsigned)((B_) * (int)SHM_V + 1024)); } while (0)
#define QKSTEP(QOFF, KCOL, QMW) do { { int ka_[4]; _Pragma("unroll") for (int d0 = 0; d0 < 4; ++d0) ka_[d0] = (kad0 + b * (int)SHM_K) ^ (d0 * 32); \
        qkt_pipe<KCOL, (QOFF) * 1024>(p0, p1, ka_, qsa); } \
        \
      if (__builtin_expect(__any((QMW) != 0.f), 0)) {   \
      int lz_ = lane; asm volatile("" : "+v"(lz_)); const bool lo_ = lz_ < 32;     \
      const bf16x8 qm = __builtin_bit_cast(bf16x8, (u32x4){lo_ ? (pg8::cvt_pk_bf16(-(QMW), 0.f) & 0xffffu) : 0u, 0u, 0u, 0u}), kones = __builtin_bit_cast(bf16x8, (u32x4){lo_ ? 0x3f80u : 0u, 0u, 0u, 0u}); \
      p0 = __builtin_amdgcn_mfma_f32_32x32x16_bf16(kones, qm, p0, 0, 0, 0); p1 = __builtin_amdgcn_mfma_f32_32x32x16_bf16(kones, qm, p1, 0, 0, 0); } } while (0)
#define T1(QOFF, KCOL, MREG, LREG, O, QMW, PA) do { f32x16 p0, p1; \
    QKSTEP(QOFF, KCOL, QMW); \
    _Pragma("unroll") for (int r = 0; r < 16; ++r) { p0[r] = __builtin_amdgcn_exp2f(p0[r]); p1[r] = __builtin_amdgcn_exp2f(p1[r]); } \
    float ps = rowsum32(p0, p1); float al = 1.f; \
    if (__builtin_expect(__any(!(ps <= 1.0995116e12f)), 0)) { asm volatile("" ::: "memory"); \
      QKSTEP(QOFF, KCOL, QMW); \
      const float pmax = rowmax32(p0, p1); const float dw = fmaxf(pmax, 0.f); \
      const float mnew = __uint_as_float(pg8::cvt_pk_bf16(MREG + dw, 0.f) << 16); const float dd = mnew - MREG; al = __builtin_amdgcn_exp2f(-dd); MREG = mnew; \
      _Pragma("unroll") for (int r = 0; r < 16; ++r) { p0[r] = __builtin_amdgcn_exp2f(p0[r] - dd); p1[r] = __builtin_amdgcn_exp2f(p1[r] - dd); } \
      ps = rowsum32(p0, p1); \
      if (__any(al < 1.f)) { int ly_ = lane; asm volatile("" : "+v"(ly_)); const int hi_ = ly_ >> 5; float* al_l = (float*)(lds + OFF_WS) + wid * 64 + 32; if (hi_ == 0) al_l[ly_ & 31] = al; asm volatile("s_waitcnt lgkmcnt(0)" ::: "memory"); \
        _Pragma("unroll") for (int d = 0; d < 4; ++d) _Pragma("unroll") for (int r = 0; r < 16; ++r) O[d][r] *= al_l[crow(r, hi_)]; } } \
    LREG = LREG * al + ps; \
    PK4(p0, 0, PA[0]); PK4(p0, 8, PA[1]); PK4(p1, 0, PA[2]); PK4(p1, 8, PA[3]); } while (0)
  asm volatile("s_waitcnt lgkmcnt(0)" ::: "memory"); KVDMA(0, 0);
#pragma unroll
  for (int d0 = 0; d0 < 8; ++d0) *(bf16x8*)(Qs + d0 * 1024) = qtmp[d0];
  asm volatile("s_waitcnt vmcnt(0)" ::: "memory");
  LBAR();
  for (int s = 0; s < NT; ++s) {
    const int b = s & 1;
    if (s + 1 < NT) KVDMA(s + 1, b ^ 1);
    if (s < nvis) {
      bf16x8 paA[4], paB[4];
      T1(0, 0, m1, l1, o1, m1, paA);
      T1(4, 128, m2, l2, o2, m2, paB);
      asm volatile("s_waitcnt lgkmcnt(0)" ::: "memory"); SBAR();
      pv_shared(o1, o2, vb0 + b * (int)SHM_V, paA, paB);
    }
    asm volatile("s_waitcnt vmcnt(0)" ::: "memory");
    LBAR();
  }
  l1_out = l1; l2_out = l2;
#undef KVDMA
#undef KVDMA1
#undef QKSTEP
#undef T1
#undef DSLOT
}
#undef LBAR

struct UnitP { int type; int b, h, qb; };
struct Tensors {
  unsigned char* ws; KArgs A;
  __device__ __forceinline__ const bf16* QA() const { return (const bf16*)(ws + WS_QA); }   __device__ __forceinline__ const bf16* QB() const { return (const bf16*)(ws + WS_QB); }
  __device__ __forceinline__ const bf16* KA() const { return (const bf16*)(ws + WS_KA); }   __device__ __forceinline__ const bf16* VA() const { return (const bf16*)(ws + WS_VA); }
  __device__ __forceinline__ const bf16* KB() const { return (const bf16*)(ws + WS_KB); }   __device__ __forceinline__ const bf16* VB() const { return (const bf16*)(ws + WS_VB); }
  __device__ __forceinline__ bf16* OA() const { return (bf16*)(ws + WS_QA); }               __device__ __forceinline__ bf16* OB() const { return (bf16*)(ws + WS_QB); }
  __device__ __forceinline__ const float* cKA() const { return A->in.cdk; }                 __device__ __forceinline__ const float* cVA() const { return A->in.cdv; }
  __device__ __forceinline__ const float* cKB() const { return A->in.csk; }                 __device__ __forceinline__ const float* cVB() const { return A->in.csv; }
  __device__ __forceinline__ const float* nK(int i) const { return A->out + (size_t)MTOK * DM + 4 * (size_t)NPROMPT * 1024 + (size_t)i * NSAMPLE * 1024; }
  __device__ __forceinline__ bf16* scr() const { return (bf16*)A->out + (size_t)MTOK * DM; }
  __device__ __forceinline__ const float* subln_g() const { return A->in.subln_g; }         __device__ __forceinline__ const float* lamp() const { return (const float*)(ws + WS_LAM); }
};
constexpr int T_SEQ = 8192, T_PAST = 1024, T_DEC = 64, M_PROMPT = 32768;

__device__ __forceinline__ void store_o_rows(const f32x16 (&o)[4], bf16* Ow, char* lds, int wid, int lane_, bool store) {
  int lane = lane_; asm volatile("" : "+v"(lane));
  const int r32 = lane & 31, hi = lane >> 5;
  bf16* stg = (bf16*)(lds + wid * 8192);
#pragma unroll
  for (int d0 = 0; d0 < 4; ++d0)
#pragma unroll
    for (int r = 0; r < 16; ++r) stg[crow(r, hi) * 128 + d0 * 32 + r32] = (bf16)(cvtpk(o[d0][r], o[d0][r]) & 0xffffu);
  asm volatile("s_waitcnt lgkmcnt(0)" ::: "memory");
  if (store) {
    const int rr = lane >> 4, ch = lane & 15;
#pragma unroll
    for (int i = 0; i < 8; ++i) { const u32x4 v = *(const u32x4*)(stg + (i * 4 + rr) * 128 + ch * 8); *(u32x4*)(Ow + (size_t)(i * 4 + rr) * LD + ch * 8) = v; }
  }
}
template <int DUMMY> __device__ __forceinline__ void epilogue_diff(const UnitP& u, const Tensors& T, f32x16 (&o1)[4], f32x16 (&o2)[4], float l1, float l2, long qrow_g, bool store, char* lds);
template <typename SRC>
__device__ __forceinline__ void unit_diff(const UnitP& u, const Tensors& T, const SRC& src, long qrow_g  , int NT, int nvis, bool store, char* lds) {
  int tid = tidx(); asm volatile("" : "+v"(tid));
  const int wid = __builtin_amdgcn_readfirstlane(tid >> 6), lane = tid & 63, r32 = lane & 31, hi = lane >> 5;
  const bf16* Qrow = T.QA() + (size_t)(qrow_g + wid * QBLK + r32) * LD + u.h * 128 + hi * 8;
  f32x16 o1[4], o2[4]; float l1, l2;
  attn_diff_pass<SRC>(Qrow, src, NT, nvis, o1, o2, l1, l2, lds);
  epilogue_diff<0>(u, T, o1, o2, l1, l2, qrow_g, store, lds);
}
template <int DUMMY>
__device__ __forceinline__ void epilogue_diff(const UnitP& u, const Tensors& T, f32x16 (&o1)[4], f32x16 (&o2)[4], float l1, float l2, long qrow_g, bool store, char* lds) {
  int tid = tidx(); asm volatile("" : "+v"(tid));
  const int wid = __builtin_amdgcn_readfirstlane(tid >> 6), lane = tid & 63, r32 = lane & 31, hi = lane >> 5;
  float* wsl = (float*)(lds + OFF_WS) + wid * 64;
  const float lam = *T.lamp();
  float g4[4];
#pragma unroll
  for (int d0 = 0; d0 < 4; ++d0) g4[d0] = T.subln_g()[d0 * 32 + r32];
  if (hi == 0) { wsl[r32] = l1; wsl[32 + r32] = l2; } asm volatile("s_waitcnt lgkmcnt(0)" ::: "memory");
  float ss[16];
#pragma unroll
  for (int r = 0; r < 16; ++r) { const float ra = __builtin_amdgcn_rcpf(wsl[crow(r, hi)]), rb = lam * __builtin_amdgcn_rcpf(wsl[32 + crow(r, hi)]); float s = 0.f;
#pragma unroll
    for (int d0 = 0; d0 < 4; ++d0) { const float v = o1[d0][r] * ra - o2[d0][r] * rb; o1[d0][r] = v; s += v * v; }
    _Pragma("unroll") for (int m_ = 1; m_ < 32; m_ <<= 1) s += __int_as_float(__builtin_amdgcn_ds_bpermute((lane ^ m_) << 2, __float_as_int(s)));
    ss[r] = __builtin_amdgcn_rsqf(s * (1.0f / 128.0f) + 1e-6f) * 0.8f; }
#pragma unroll
  for (int d0 = 0; d0 < 4; ++d0) { const float g = g4[d0];
#pragma unroll
    for (int r = 0; r < 16; ++r) o1[d0][r] = o1[d0][r] * ss[r] * g; }
  store_o_rows(o1, T.OA() + (size_t)(qrow_g + wid * QBLK) * LD + u.h * 128, lds, wid, lane, store);
  asm volatile("s_waitcnt lgkmcnt(0)" ::: "memory"); __builtin_amdgcn_s_barrier(); asm volatile("" ::: "memory");
}
template <typename SRC, bool EARLY>
__device__ __forceinline__ void unit_sb(const UnitP& u, const Tensors& T, const SRC& src, long qrow_g, int qpos0  , int NT, bool store, bool active, char* lds) {
  int tid = tidx(); asm volatile("" : "+v"(tid));
  const int wid = __builtin_amdgcn_readfirstlane(tid >> 6), lane = tid & 63, r32 = lane & 31, hi = lane >> 5;
  const bf16* Qrow = T.QB() + (size_t)(qrow_g + wid * QBLK + r32) * LD + u.h * 128 + hi * 8;
  f32x16 o[4]; float l_dummy;
  attn_pass_simple<1, SRC, EARLY>(Qrow, src, NT, 0, qpos0 + wid * QBLK + r32, 0, o, l_dummy, lds, active);
  store_o_rows(o, T.OB() + (size_t)(qrow_g + wid * QBLK) * LD + u.h * 128, lds, wid, lane, store);
  asm volatile("s_waitcnt lgkmcnt(0)" ::: "memory"); __builtin_amdgcn_s_barrier(); asm volatile("" ::: "memory");
}
#ifndef SB_EARLY_EXIT
#define SB_EARLY_EXIT true
#endif
__device__ __forceinline__ void run_unit(const UnitP& u, const Tensors& T, char* lds, bool dostore = true) {
  int tid0_ = tidx(); asm volatile("" : "+v"(tid0_));
  const int wid = __builtin_amdgcn_readfirstlane(tid0_ >> 6);
  if (u.type < 2) {
    const long row0 = (long)u.b * T_SEQ + u.qb * 256; const size_t kvoff = (size_t)u.b * T_SEQ * LD + u.h * 128;
    const int NT = 4 * u.qb + 4;
    if (u.type == 0) { KVLin s{T.KA() + kvoff, T.VA() + kvoff};
      unit_diff<KVLin>(u, T, s, row0, NT, 4 * u.qb + (wid >> 1) + 1, dostore, lds); }
    if (u.type == 1) { KVLin s{T.KB() + kvoff, T.VB() + kvoff};
      unit_sb<KVLin, SB_EARLY_EXIT>(u, T, s, row0, u.qb * 256, NT, dostore, true, lds); }
  } else {
    const long row0 = (long)M_PROMPT + u.b * T_DEC; const size_t coff = (size_t)u.b * T_PAST * LD + u.h * 128, noff = (size_t)u.b * T_DEC * LD + u.h * 128;
    const int NT = 18; const bool store = dostore && wid < 2;
    if (u.type == 2) {
      bf16* sk = T.scr() + (size_t)blockIdx.x * (2 * 1088 * 128); bf16* sv = sk + 1088 * 128;
      { int tid = tidx(); asm volatile("" : "+v"(tid));
        constexpr int NPIECE = 1088 * 16;
        for (int c0 = tid; c0 < NPIECE; c0 += 4 * 512) { f32x8 kx[4], vx[4];
#pragma unroll
          for (int j = 0; j < 4; ++j) { const int c = c0 + 512 * j; if (c < NPIECE) { const int row = c >> 4, c8 = (c & 15) * 8;
            const float* kr = row < T_PAST ? T.cKA() + coff + (size_t)row * LD : T.nK(0) + noff + (size_t)(row - T_PAST) * LD;
            const float* vr = row < T_PAST ? T.cVA() + coff + (size_t)row * LD : T.nK(1) + noff + (size_t)(row - T_PAST) * LD;
            kx[j] = *reinterpret_cast<const f32x8*>(kr + c8); vx[j] = *reinterpret_cast<const f32x8*>(vr + c8); } }
#pragma unroll
          for (int j = 0; j < 4; ++j) { const int c = c0 + 512 * j; if (c < NPIECE) { const int row = c >> 4, c8 = (c & 15) * 8;
            u32x4 wk = {cvtpk(kx[j][0], kx[j][1]), cvtpk(kx[j][2], kx[j][3]), cvtpk(kx[j][4], kx[j][5]), cvtpk(kx[j][6], kx[j][7])};
            u32x4 wv = {cvtpk(vx[j][0], vx[j][1]), cvtpk(vx[j][2], vx[j][3]), cvtpk(vx[j][4], vx[j][5]), cvtpk(vx[j][6], vx[j][7])};
            *(u32x4*)(sk + (size_t)row * 128 + c8) = wk; *(u32x4*)(sv + (size_t)row * 128 + c8) = wv; } } }
        asm volatile("s_waitcnt vmcnt(0)" ::: "memory"); __syncthreads();
        __builtin_amdgcn_fence(__ATOMIC_ACQUIRE, "agent"); asm volatile("s_waitcnt vmcnt(0)" ::: "memory"); }
      KVScr s{sk, sv};
      unit_diff<KVScr>(u, T, s, row0, 17, __builtin_amdgcn_readfirstlane(wid) < 2 ? 17 : 0, store, lds); }
    if (u.type == 3) { KVTwo s{T.cKB() + coff, T.cVB() + coff, T.nK(2) + noff, T.nK(3) + noff, T_PAST};
      unit_sb<KVTwo, SB_EARLY_EXIT>(u, T, s, row0, T_PAST, NT, store, __builtin_amdgcn_readfirstlane(wid) < 2, lds); }
  }
}
#undef KSWZ
#undef SBAR
#undef PK4
#undef SBGRP
}
#define GAS __attribute__((address_space(1)))
#define LAS __attribute__((address_space(3)))
typedef unsigned short bf16;
typedef unsigned v4u __attribute__((ext_vector_type(4)));
typedef float f32x4 __attribute__((ext_vector_type(4)));
typedef short bf16x8 __attribute__((ext_vector_type(8)));
typedef GAS unsigned gu32;
typedef GAS unsigned long long gu64;
#define RLX_AGENT __ATOMIC_RELAXED, __HIP_MEMORY_SCOPE_AGENT
#define LDS_WAIT() asm volatile("s_waitcnt lgkmcnt(0)" ::: "memory")
#define VM_WAIT() asm volatile("s_waitcnt vmcnt(0)" ::: "memory")
__device__ __forceinline__ unsigned long long rt() { return __builtin_amdgcn_s_memrealtime(); }
__device__ __forceinline__ unsigned f2bf(float f) { unsigned u = __builtin_bit_cast(unsigned, f); return (u + 0x7fffu + ((u >> 16) & 1u)) >> 16; }
__device__ __forceinline__ unsigned pk2(float lo, float hi) { return f2bf(lo) | (f2bf(hi) << 16); }

#define XB_TMO      128
#define XB_XCNT(j)  (256  + 64 * (j))
#define XB_XSUB(j)  (1280 + 64 * (j))
#define XB_XGEN(j)  (2304 + 64 * (j))
#define XB_TOP      3328
#define XB_TOPGEN   3392
#define XCD_BAR_WORDS 3456
#define XB_SPIN_CAP (1u << 18)

__device__ __forceinline__ unsigned xb_ld(unsigned* p)              { return __hip_atomic_load(p, __ATOMIC_RELAXED, __HIP_MEMORY_SCOPE_AGENT); }
__device__ __forceinline__ unsigned xb_add(unsigned* p, unsigned v) { return __hip_atomic_fetch_add(p, v, __ATOMIC_RELAXED, __HIP_MEMORY_SCOPE_AGENT); }
__device__ __forceinline__ unsigned xb_xcc_id() { return (unsigned)__builtin_amdgcn_s_getreg((3 << 11) | 20) & 0xFu; }
#define XB_SPIN(cond, bar) do { unsigned _sp = 0; while (cond) { __builtin_amdgcn_s_sleep(1); \
    if ((++_sp & 255u) == 0u) { if (xb_ld(&(bar)[XB_TMO])) break; if (_sp > XB_SPIN_CAP) { atomicAdd(&(bar)[XB_TMO], 1u); break; } } } } while (0)

struct XcdBarrier {
    unsigned* bar; unsigned x;
    volatile LAS unsigned* st;
};

__device__ __forceinline__ XcdBarrier xcd_barrier_post(unsigned* bar, volatile LAS unsigned* st) {
    XcdBarrier b; b.bar = bar; b.x = xb_xcc_id(); b.st = st;
    if (tidx() == 0) (void)xb_add(&bar[XB_XCNT(b.x)], 1u);
    return b;
}
__device__ __forceinline__ void xcd_barrier_complete(unsigned* bar, unsigned x, unsigned& nloc, unsigned& nx) {
    const unsigned G = gridDim.x * gridDim.y * gridDim.z;
    unsigned sum, cnt, mine, sp = 0u;
    for (;;) {
        sum = 0u; cnt = 0u; mine = 0u;
#pragma unroll
        for (unsigned j = 0; j < 16; ++j) { const unsigned c = xb_ld(&bar[XB_XCNT(j)]); sum += c; cnt += (c > 0u) ? 1u : 0u; mine = (j == x) ? c : mine; }
        if (sum == G) break;
        __builtin_amdgcn_s_sleep(1);
        if ((++sp & 255u) == 0u) { if (xb_ld(&bar[XB_TMO])) break; if (sp > XB_SPIN_CAP) { atomicAdd(&bar[XB_TMO], 1u); break; } }
    }
    nloc = mine > 0u ? mine : 1u; nx = cnt > 0u ? cnt : 1u;
}

__device__ __forceinline__ void xcd_barrier(const XcdBarrier& b) {
    asm volatile("s_waitcnt vmcnt(0)" ::: "memory");
    __syncthreads();
    if (tidx() == 0) {
        unsigned* bar = b.bar;
        __builtin_amdgcn_s_waitcnt(0);
        unsigned nloc = b.st[0], nx = b.st[1];
        if (nloc == 0u) { xcd_barrier_complete(bar, b.x, nloc, nx); b.st[0] = nloc; b.st[1] = nx; }
        const unsigned old = xb_add(&bar[XB_XSUB(b.x)], 1u);
        const unsigned gen = old / nloc;
        if (old + 1u == (gen + 1u) * nloc) {
            __builtin_amdgcn_fence(__ATOMIC_RELEASE, "agent");
            asm volatile("s_waitcnt vmcnt(0)" ::: "memory");
            const unsigned og = xb_add(&bar[XB_TOP], 1u);
            const unsigned tg = og / nx;
            if (og + 1u == (tg + 1u) * nx) xb_add(&bar[XB_TOPGEN], 1u);
            else XB_SPIN(xb_ld(&bar[XB_TOPGEN]) == tg, bar);
            __builtin_amdgcn_fence(__ATOMIC_ACQUIRE, "agent");
            xb_add(&bar[XB_XGEN(b.x)], 1u);
            asm volatile("s_waitcnt vmcnt(0)" ::: "memory");
        } else {
            XB_SPIN(xb_ld(&bar[XB_XGEN(b.x)]) == gen, bar);
            __builtin_amdgcn_fence(__ATOMIC_ACQUIRE, "agent");
            asm volatile("s_waitcnt vmcnt(0)" ::: "memory");
        }
    }
    __syncthreads();
}

static_assert(WAVETAB_OFF == MISC_OFF + 128 && WAVETAB_OFF + 256 <= (int)att::OFF_WS && (int)att::OFF_DMA + 512 * 16 <= LDS_BYTES && att::OFF_DMA % 16 == 0, "LDS map");
static_assert(att::SHM_ATTN <= RING_BYTES, "attention scratch fits the ring");

__device__ __forceinline__ float wave_sum(float v) {
#pragma unroll
    for (int o = 1; o < 64; o <<= 1) v += __shfl_xor(v, o);
    return v;
}
__device__ __forceinline__ void transpose_item(const float* W, int K, int N, bf16* WT, int k0, int n0, int drow0, LAS float* scr, int lane, const float* gk) {
    { const int ks = lane >> 3, n4 = (lane & 7) * 4; f32x4 w[8];
#pragma unroll
      for (int i = 0; i < 8; ++i) w[i] = *(const GAS f32x4*)(W + (size_t)(k0 + i * 8 + ks) * N + n0 + n4);
      if (gk) {
#pragma unroll
        for (int i = 0; i < 8; ++i) w[i] = w[i] * gk[k0 + i * 8 + ks]; }
#pragma unroll
      for (int i = 0; i < 8; ++i) { LAS float* d = scr + (i * 8 + ks) * 33 + n4; d[0] = w[i].x; d[1] = w[i].y; d[2] = w[i].z; d[3] = w[i].w; } }
    LDS_WAIT(); asm volatile("" ::: "memory");
    const int c = lane & 7;
#pragma unroll
    for (int j = 0; j < 4; ++j) { const int n = (lane >> 3) + 8 * j; const LAS float* s = scr + (8 * c) * 33 + n;
        v4u o; o.x = pk2(s[0 * 33], s[1 * 33]); o.y = pk2(s[2 * 33], s[3 * 33]); o.z = pk2(s[4 * 33], s[5 * 33]); o.w = pk2(s[6 * 33], s[7 * 33]);
        *(GAS v4u*)(WT + (size_t)(drow0 + n) * K + k0 + 8 * c) = o; }
    LDS_WAIT(); asm volatile("" ::: "memory");
}
__device__ __forceinline__ void transpose_item8(const float* W, unsigned char* WT8, int item, LAS float* scr, int lane) {
    const int kb = item >> 6, nb = item & 63, k0 = 64 * kb, n0 = 32 * nb; const int c = lane & 7;
    if (kb >= DFF / 64) {
#pragma unroll
        for (int j = 0; j < 4; ++j) { const int n = (lane >> 3) + 8 * j; *(GAS unsigned long long*)(WT8 + (size_t)(n0 + n) * pg8::ACT8_LD + k0 + 8 * c) = 0ull; }
        return; }
    { const int ks = lane >> 3, n4 = (lane & 7) * 4; f32x4 w[8];
#pragma unroll
      for (int i = 0; i < 8; ++i) w[i] = *(const GAS f32x4*)(W + (size_t)(k0 + i * 8 + ks) * DM + n0 + n4);
#pragma unroll
      for (int i = 0; i < 8; ++i) { LAS float* d = scr + (i * 8 + ks) * 33 + n4; d[0] = w[i].x; d[1] = w[i].y; d[2] = w[i].z; d[3] = w[i].w; } }
    LDS_WAIT(); asm volatile("" ::: "memory");
#pragma unroll
    for (int j = 0; j < 4; ++j) { const int n = (lane >> 3) + 8 * j; const LAS float* s = scr + (8 * c) * 33 + n; constexpr float SC = pg8::W8_SCALE;
        const unsigned lo = pg8::pk4_fp8(s[0 * 33] * SC, s[1 * 33] * SC, s[2 * 33] * SC, s[3 * 33] * SC), hi = pg8::pk4_fp8(s[4 * 33] * SC, s[5 * 33] * SC, s[6 * 33] * SC, s[7 * 33] * SC);
        *(GAS unsigned long long*)(WT8 + (size_t)(n0 + n) * pg8::ACT8_LD + k0 + 8 * c) = (unsigned long long)lo | ((unsigned long long)hi << 32); }
    LDS_WAIT(); asm volatile("" ::: "memory");
}
__device__ __forceinline__ void transpose_matrix_item(const float* W, int K, int N, bf16* WT, int row_off, int gu, int item, LAS float* scr, int lane, const float* gk = nullptr) {
    const int nblk = N / 32, kb = item / nblk, nb = item % nblk, k0 = 64 * kb, n0 = 32 * nb;
    const int drow0 = gu == 0 ? row_off + n0 : 256 * (n0 >> 7) + (n0 & 127) + (gu == 2 ? 128 : 0);
    transpose_item(W, K, N, WT, k0, n0, drow0, scr, lane, gk);
}
__device__ __forceinline__ f32x4 bf4(unsigned long long w) { const unsigned lo = (unsigned)w, hi = (unsigned)(w >> 32);
    return (f32x4){__uint_as_float(lo << 16), __uint_as_float(lo & 0xffff0000u), __uint_as_float(hi << 16), __uint_as_float(hi & 0xffff0000u)}; }
template <bool HAS_D, bool RES_BF, bool OUT_F32>
__device__ __forceinline__ void thin_row(const void* res, const bf16* d, float coef, const float* gpost, float* out_f32, bf16* hb, float* rs_out, int lane) {
    f32x4 v[8];
    if (RES_BF) { const GAS unsigned long long* xr = (const GAS unsigned long long*)res + lane;
#pragma unroll
        for (int j = 0; j < 8; ++j) v[j] = bf4(__builtin_nontemporal_load(xr + 64 * j)); }
    else { const GAS f32x4* xr = (const GAS f32x4*)res + lane;
#pragma unroll
        for (int j = 0; j < 8; ++j) v[j] = __builtin_nontemporal_load(xr + 64 * j); }
    if (HAS_D) {
        const GAS unsigned long long* dr = (const GAS unsigned long long*)d + lane;
        f32x4 dv[8]; float s = 0.f;
#pragma unroll
        for (int j = 0; j < 8; ++j) { dv[j] = bf4(__builtin_nontemporal_load(dr + 64 * j));
            s += (dv[j].x * dv[j].x + dv[j].y * dv[j].y) + (dv[j].z * dv[j].z + dv[j].w * dv[j].w); }
        const float rstd = coef / sqrtf(wave_sum(s) * (1.f / DM) + EPS);
        const GAS f32x4* gp = (const GAS f32x4*)gpost + lane;
#pragma unroll
        for (int j = 0; j < 8; ++j) { const f32x4 g = gp[64 * j]; v[j] = v[j] + dv[j] * g * rstd; }
    }
    if (OUT_F32) { GAS f32x4* orow = (GAS f32x4*)out_f32 + lane;
#pragma unroll
        for (int j = 0; j < 8; ++j) __builtin_nontemporal_store(v[j], orow + 64 * j); }
    else {
        float s2 = 0.f;
#pragma unroll
        for (int j = 0; j < 8; ++j) s2 += (v[j].x * v[j].x + v[j].y * v[j].y) + (v[j].z * v[j].z + v[j].w * v[j].w);
        GAS unsigned long long* o8 = (GAS unsigned long long*)hb + lane;
#pragma unroll
        for (int j = 0; j < 8; ++j) o8[64 * j] = (unsigned long long)pk2(v[j].x, v[j].y) | ((unsigned long long)pk2(v[j].z, v[j].w) << 32);
        const float rstd = 1.f / sqrtf(wave_sum(s2) * (1.f / DM) + EPS);
        if (lane == 0) *rs_out = rstd;
    }
}
__device__ __forceinline__ void unit_decode(int u, att::UnitP& p) {
    if (u < 1024) { p.type = 0; p.b = u >> 8; p.h = (u >> 5) & 7; p.qb = u & 31; }
    else if (u < 2048) { const int v = u - 1024; p.type = 1; p.b = v >> 8; p.h = (v >> 5) & 7; p.qb = v & 31; }
    else if (u < 2304) { const int v = u - 2048; p.type = 2; p.b = v >> 3; p.h = v & 7; p.qb = 0; }
    else { const int v = u - 2304; p.type = 3; p.b = v >> 3; p.h = v & 7; p.qb = 0; }
}
__device__ __forceinline__ int unit_at(int p) {
    if (p < 864) return (p & 31) * 32 + 31 - (p >> 5);
    if (p < 1120) return 2048 + (p - 864);
    if (p < 1280) return ((p - 1120) & 31) * 32 + 4 - ((p - 1120) >> 5);
    if (p < 1952) return 1024 + ((p - 1280) & 31) * 32 + 31 - ((p - 1280) >> 5);
    if (p < 2208) return 2304 + (p - 1952);
    return 1024 + ((p - 2208) & 31) * 32 + 10 - ((p - 2208) >> 5);
}
constexpr int N_SIDE = 64;
__device__ __forceinline__ KArgs kargs() { KArgs p = (KArgs)__builtin_amdgcn_kernarg_segment_ptr(); asm volatile("" : "+s"(p)); return p; }
#define ENV() KArgs A_ = kargs(); unsigned char* const ws = A_->ws; (void)ws; const int G = (int)gridDim.x, bx = (int)blockIdx.x; (void)G; (void)bx; \
    int tid = tidx(); asm volatile("" : "+v"(tid)); const int lane = tid & 63, wave = __builtin_amdgcn_readfirstlane(tid >> 6); (void)lane; (void)wave; \
    const int vcu = (G % 8 == 0) ? (bx % 8) * (G / 8) + bx / 8 : bx; const int gw = vcu * NWAVES + wave, NGW = G * NWAVES; (void)gw; (void)NGW
#define WSP(T, off) ((T*)(ws + (off)))

__global__ void __launch_bounds__(NWAVES * 64, 2) fwd_kernel(Args args) {
    extern __shared__ __attribute__((aligned(16))) unsigned char lds[];
    LAS unsigned char* ldsl = (LAS unsigned char*)lds;
    volatile LAS unsigned* MISC = (volatile LAS unsigned*)(ldsl + MISC_OFF);
    for (int u = threadIdx.x; u < (LDS_BYTES - LDSCTL_OFF) / 4; u += NWAVES * 64) ((LAS unsigned*)(ldsl + LDSCTL_OFF))[u] = 0u;
    __syncthreads();
    if ((threadIdx.x & 63) == 0) ((LAS int*)(ldsl + WAVETAB_OFF))[__builtin_amdgcn_s_getreg(0x2804)] = (int)(threadIdx.x >> 6);
    __syncthreads();
    XcdBarrier bar = xcd_barrier_post((unsigned*)((gu32*)(args.ws + WS_CTL) + CW_BAR), MISC + 8);

    {
        ENV();
        LAS float* scr = (LAS float*)(ldsl + RING_OFF + wave * 16384);
        bf16* WIN_T = WSP(bf16, WS_WIN); bf16* F1GU = WSP(bf16, WS_F1GU); bf16* F1D = WSP(bf16, WS_F1D); bf16* XN = WSP(bf16, WS_XN);
        constexpr int I_WIN = (DM / 64) * (INCOLS / 32), I_GU = (DM / 64) * (DFF / 32), I_DN = (DFF / 64) * (DM / 32);
        constexpr int NITEMS = I_WIN + 2 * I_GU + I_DN;
        for (int it = gw; it < NITEMS; it += NGW) {
            int r = it;
            if (r < I_GU) { transpose_matrix_item(A_->in.f1g, DM, DFF, F1GU, 0, 1, r, scr, lane, A_->in.n1a); continue; } r -= I_GU;
            if (r < I_GU) { transpose_matrix_item(A_->in.f1u, DM, DFF, F1GU, 0, 2, r, scr, lane, A_->in.n1a); continue; } r -= I_GU;
            if (r < I_DN) { transpose_matrix_item(A_->in.f1d, DFF, DM, F1D, 0, 0, r, scr, lane); continue; } r -= I_DN;
            transpose_matrix_item(A_->in.w_in, DM, INCOLS, WIN_T, 0, 0, r, scr, lane, A_->in.nma);
        }
        { const float* xp = A_->in.x_prompt; const float* xs = A_->in.x_sample; float* RS = WSP(float, WS_RSTD);
          for (int m = gw; m < MTOK; m += NGW) {
            const float* xr = m < NPROMPT ? xp + (size_t)m * DM : xs + (size_t)(m - NPROMPT) * DM;
            thin_row<false, false, false>(xr, nullptr, 0.f, nullptr, nullptr, XN + (size_t)m * DM, RS + m, lane); } }
        if (bx == 0 && wave == 0) {
            const float s1 = wave_sum(A_->in.lq1[lane] * A_->in.lk1[lane]), s2 = wave_sum(A_->in.lq2[lane] * A_->in.lk2[lane]);
            if (lane == 0) *WSP(float, WS_LAM) = __expf(s1) - __expf(s2) + 0.2f;
        }
    }
    xcd_barrier(bar);

    { ENV(); pg8::Gemm g{WSP(bf16, WS_XN), WSP(bf16, WS_F1GU), MTOK, 2 * DFF, DM}; pg8::StaticOrder S; S.init(MTOK, 2 * DFF, G, bx);
      pg8::EpiSwiGLU E{WSP(bf16, WS_BIG), DFF, WSP(float, WS_RSTD)};
      pg8::gemm_phase<pg8::EpiSwiGLU, pg8::StaticOrder, true, true>(ldsl + RING_OFF, g, S, E); }
    xcd_barrier(bar);
    { ENV(); pg8::Gemm g{WSP(bf16, WS_BIG), WSP(bf16, WS_F1D), NPROMPT, DM, DFF}; pg8::StaticOrder S; S.init(NPROMPT, DM, G, bx);
      pg8::EpiPlain E{WSP(bf16, WS_D), DM};
      pg8::gemm_phase<pg8::EpiPlain, pg8::StaticOrder, true, true>(ldsl + RING_OFF, g, S, E); }
    xcd_barrier(bar);
    { ENV();
      if (bx < N_SIDE) { pg8::Gemm g{WSP(bf16, WS_BIG), WSP(bf16, WS_F1D), MTOK, DM, DFF}; pg8::SampleOrder S{DM / 256, N_SIDE, bx};
        pg8::EpiPlain E{WSP(bf16, WS_D), DM};
        pg8::gemm_phase<pg8::EpiPlain, pg8::SampleOrder, true, true>(ldsl + RING_OFF, g, S, E); }
      else { const float* xp = A_->in.x_prompt; const float* gpo = A_->in.n1b; bf16* DB = WSP(bf16, WS_D); bf16* XN = WSP(bf16, WS_XN); float* RS = WSP(float, WS_RSTD);
        for (int m = (bx - N_SIDE) * NWAVES + wave; m < NPROMPT; m += (G - N_SIDE) * NWAVES)
          thin_row<true, true, false>(XN + (size_t)m * DM, DB + (size_t)m * DM, 0.5f, gpo, nullptr, XN + (size_t)m * DM, RS + m, lane); } }
    xcd_barrier(bar);
    { ENV(); const float* xs = A_->in.x_sample; const float* gpo = A_->in.n1b; bf16* DB = WSP(bf16, WS_D); bf16* XN = WSP(bf16, WS_XN); float* RS = WSP(float, WS_RSTD);
      for (int m = NPROMPT + gw; m < MTOK; m += NGW)
        thin_row<true, true, false>(XN + (size_t)m * DM, DB + (size_t)m * DM, 0.5f, gpo, nullptr, XN + (size_t)m * DM, RS + m, lane); }
    xcd_barrier(bar);
    { ENV(); pg8::Gemm g{WSP(bf16, WS_XN), WSP(bf16, WS_WIN), MTOK, INCOLS, DM}; pg8::StaticOrder S; S.init(MTOK, INCOLS, G, bx);
      float* okA_p = A_->out + (size_t)MTOK * DM;
      float* ovA_p = okA_p + (size_t)NPROMPT * 1024; float* okB_p = ovA_p + (size_t)NPROMPT * 1024; float* ovB_p = okB_p + (size_t)NPROMPT * 1024;
      float* okA_s = ovB_p + (size_t)NPROMPT * 1024; float* ovA_s = okA_s + (size_t)NSAMPLE * 1024; float* okB_s = ovA_s + (size_t)NSAMPLE * 1024; float* ovB_s = okB_s + (size_t)NSAMPLE * 1024;
      pg8::EpiWin E{WSP(bf16, WS_QA), WSP(bf16, WS_KA), WSP(bf16, WS_VA), WSP(bf16, WS_QB), WSP(bf16, WS_KB), WSP(bf16, WS_VB), WSP(bf16, WS_SGA), WSP(bf16, WS_SGB),
                    okA_p, ovA_p, okB_p, ovB_p, okA_s, ovA_s, okB_s, ovB_s, 0.18033688011112042f, 0.12751743082459868f, WSP(float, WS_RSTD)};
      pg8::gemm_phase<pg8::EpiWin, pg8::StaticOrder, true, true>(ldsl + RING_OFF, g, S, E);
      constexpr int NLAST = (MTOK / 256) * (INCOLS / 256) - 21 * 256;
      if (G == 256 ? bx >= NLAST : true) {
        LAS float* scr = (LAS float*)(ldsl + RING_OFF + wave * 16384);
        bf16* F2GU = WSP(bf16, WS_F2GU); bf16* F2D = WSP(bf16, WS_F2D); bf16* WAB = WSP(bf16, WS_WAB); bf16* WO_T = WSP(bf16, WS_WO);
        constexpr int I_GU = (DM / 64) * (DFF / 32), I_DN = (pg8::ACT8_LD / 64) * (DM / 32), I_UP = (1024 / 64) * (DM / 32), I_WO = (DM / 64) * (DM / 32);
        constexpr int NLATE = 2 * I_GU + I_DN + 2 * I_UP + I_WO;
        const int first = G == 256 ? (bx - NLAST) * NWAVES + wave : gw, stride = G == 256 ? (G - NLAST) * NWAVES : NGW;
        for (int it = first; it < NLATE; it += stride) {
            int r = it;
            if (r < I_GU) { transpose_matrix_item(A_->in.f2g, DM, DFF, F2GU, 0, 1, r, scr, lane, A_->in.n2a); continue; } r -= I_GU;
            if (r < I_GU) { transpose_matrix_item(A_->in.f2u, DM, DFF, F2GU, 0, 2, r, scr, lane, A_->in.n2a); continue; } r -= I_GU;
            if (r < I_DN) { transpose_item8(A_->in.f2d, (unsigned char*)F2D, r, scr, lane); continue; } r -= I_DN;
            if (r < I_UP) { transpose_matrix_item(A_->in.w_up_a, 1024, DM, WAB, 0, 0, r, scr, lane); continue; } r -= I_UP;
            if (r < I_UP) { transpose_matrix_item(A_->in.w_up_b, 1024, DM, WAB, 2048, 0, r, scr, lane); continue; } r -= I_UP;
            transpose_matrix_item(A_->in.w_o, DM, DM, WO_T, 0, 0, r, scr, lane);
        } } }
    xcd_barrier(bar);
    {
        for (;;) {
            ENV();
            if (tid == 0) MISC[16] = __hip_atomic_fetch_add((gu32*)(ws + WS_CTL) + CW_QUEUE, 1u, __ATOMIC_RELAXED, __HIP_MEMORY_SCOPE_AGENT);
            __syncthreads();
            const unsigned qi = MISC[16];
            __syncthreads();
            if (qi >= (unsigned)N_UNITS) break;
            att::Tensors T{ws, A_};
            att::UnitP up; unit_decode(unit_at((int)qi), up);
            att::run_unit(up, T, (char*)lds + RING_OFF);
        }
    }
    xcd_barrier(bar);
    { ENV(); pg8::Gemm g{WSP(bf16, WS_QA), WSP(bf16, WS_WAB), 2 * MTOK, 4096, 1024}; pg8::UpOrder S; S.init(G, bx);
      pg8::EpiUpGate E{WSP(bf16, WS_SGA), WSP(bf16, WS_SGB), (bf16*)A_->out};
      pg8::gemm_phase<pg8::EpiUpGate, pg8::UpOrder, true, true>(ldsl + RING_OFF, g, S, E); }
    xcd_barrier(bar);
    { ENV(); pg8::Gemm g{(const bf16*)A_->out, WSP(bf16, WS_WO), MTOK, DM, DM}; pg8::StaticOrder S; S.init(MTOK, DM, G, bx);
      pg8::EpiPlain E{WSP(bf16, WS_D), DM};
      pg8::gemm_phase<pg8::EpiPlain, pg8::StaticOrder, true, true>(ldsl + RING_OFF, g, S, E); }
    xcd_barrier(bar);
    { ENV(); const float* gpo = A_->in.nmb; bf16* DB = WSP(bf16, WS_D); bf16* XN = WSP(bf16, WS_XN); float* RS = WSP(float, WS_RSTD);
      for (int m = gw; m < MTOK; m += NGW)
        thin_row<true, true, false>(XN + (size_t)m * DM, DB + (size_t)m * DM, 1.0f, gpo, nullptr, XN + (size_t)m * DM, RS + m, lane); }
    xcd_barrier(bar);
    { ENV(); pg8::Gemm g{WSP(bf16, WS_XN), WSP(bf16, WS_F2GU), MTOK, 2 * DFF, DM}; pg8::StaticOrder S; S.init(MTOK, 2 * DFF, G, bx);
      pg8::EpiSwiGLU8 E{WSP(unsigned char, WS_BIG), WSP(float, WS_RSTD)};
      pg8::gemm_phase<pg8::EpiSwiGLU8, pg8::StaticOrder, true, true>(ldsl + RING_OFF, g, S, E); }
    xcd_barrier(bar);
    { ENV(); pg8::Gemm g{WSP(bf16, WS_BIG), WSP(bf16, WS_F2D), NPROMPT, DM, pg8::ACT8_LD / 2}; pg8::StaticOrder S; S.init(NPROMPT, DM, G, bx);
      pg8::EpiPlainS E{WSP(bf16, WS_D), DM, 1.f / (pg8::ACT8_SCALE * pg8::W8_SCALE)};
      pg8::gemm_phase<pg8::EpiPlainS, pg8::StaticOrder, true, true, true>(ldsl + RING_OFF, g, S, E); }
    xcd_barrier(bar);
    { ENV();
      if (bx < N_SIDE) { pg8::Gemm g{WSP(bf16, WS_BIG), WSP(bf16, WS_F2D), MTOK, DM, pg8::ACT8_LD / 2}; pg8::SampleOrder S{DM / 256, N_SIDE, bx};
        pg8::EpiPlainS E{WSP(bf16, WS_D), DM, 1.f / (pg8::ACT8_SCALE * pg8::W8_SCALE)};
        pg8::gemm_phase<pg8::EpiPlainS, pg8::SampleOrder, true, true, true>(ldsl + RING_OFF, g, S, E); }
      else { const float* gpo = A_->in.n2b; float* out_y = A_->out; bf16* DB = WSP(bf16, WS_D); const bf16* XN = WSP(bf16, WS_XN);
        for (int m = (bx - N_SIDE) * NWAVES + wave; m < NPROMPT; m += (G - N_SIDE) * NWAVES)
          thin_row<true, true, true>(XN + (size_t)m * DM, DB + (size_t)m * DM, 0.5f, gpo, out_y + (size_t)m * DM, nullptr, nullptr, lane); } }
    xcd_barrier(bar);
    { ENV(); const float* gpo = A_->in.n2b; float* out_y = A_->out; bf16* DB = WSP(bf16, WS_D); const bf16* XN = WSP(bf16, WS_XN);
      for (int m = NPROMPT + gw; m < MTOK; m += NGW)
        thin_row<true, true, true>(XN + (size_t)m * DM, DB + (size_t)m * DM, 0.5f, gpo, out_y + (size_t)m * DM, nullptr, nullptr, lane); }
}

extern "C" void kernel_launch(void* const* d_in, const int* in_sizes, int n_in, void* d_out, int out_size, void* d_ws, size_t ws_size, hipStream_t stream) {
    static int grid = 0;
    if (grid == 0) {
        const long want_out = (long)MTOK * DM + 4L * MTOK * 1024;
        if (n_in != 27 || in_sizes[0] != NPROMPT * DM || in_sizes[1] != NSAMPLE * DM || (long)out_size != want_out || ws_size < WS_END) {
            fprintf(stderr, "kernel_launch: shape mismatch: n_in %d in0 %d in1 %d out %d (want %ld) ws %zu (need %zu); nothing launched\n", n_in, n_in > 0 ? in_sizes[0] : -1, n_in > 1 ? in_sizes[1] : -1, out_size, want_out, ws_size, (size_t)WS_END);
            grid = -1; return; }
        int dev = 0, cus = 0, per_cu = 0;
        if (hipGetDevice(&dev) != hipSuccess || hipDeviceGetAttribute(&cus, hipDeviceAttributeMultiprocessorCount, dev) != hipSuccess) { fprintf(stderr, "kernel_launch: device query failed\n"); grid = -1; return; }
        if (hipFuncSetAttribute((const void*)fwd_kernel, hipFuncAttributeMaxDynamicSharedMemorySize, LDS_BYTES) != hipSuccess) { fprintf(stderr, "kernel_launch: hipFuncSetAttribute failed\n"); grid = -1; return; }
        if (hipOccupancyMaxActiveBlocksPerMultiprocessor(&per_cu, (const void*)fwd_kernel, NWAVES * 64, LDS_BYTES) != hipSuccess || per_cu < 1) {
            fprintf(stderr, "kernel_launch: occupancy query reports %d workgroups per CU; nothing launched\n", per_cu); (void)hipGetLastError(); grid = -1; return; }
        (void)hipGetLastError();
        grid = cus;
    }
    if (grid < 0) return;
    if (hipMemsetAsync((char*)d_ws + WS_CTL, 0, CTL_ZERO_BYTES, stream) != hipSuccess) { fprintf(stderr, "kernel_launch: hipMemsetAsync failed\n"); return; }
    Args a{};
    const float* const* p = (const float* const*)d_in;
    a.in.x_prompt = p[0]; a.in.x_sample = p[1]; a.in.cdk = p[2]; a.in.cdv = p[3]; a.in.csk = p[4]; a.in.csv = p[5]; a.in.w_in = p[6]; a.in.w_up_a = p[7]; a.in.w_up_b = p[8]; a.in.w_o = p[9];
    a.in.lq1 = p[10]; a.in.lk1 = p[11]; a.in.lq2 = p[12]; a.in.lk2 = p[13]; a.in.subln_g = p[14];
    a.in.n1a = p[15]; a.in.n1b = p[16]; a.in.nma = p[17]; a.in.nmb = p[18]; a.in.n2a = p[19]; a.in.n2b = p[20];
    a.in.f1g = p[21]; a.in.f1u = p[22]; a.in.f1d = p[23]; a.in.f2g = p[24]; a.in.f2u = p[25]; a.in.f2d = p[26];
    a.out = (float*)d_out; a.ws = (unsigned char*)d_ws;
    hipLaunchKernelGGL(fwd_kernel, dim3(grid), dim3(NWAVES * 64), LDS_BYTES, stream, a);
    const hipError_t le = hipPeekAtLastError();
    if (le != hipSuccess) fprintf(stderr, "kernel_launch: launch failed: %s\n", hipGetErrorName(le));
}
```

```cpp
#include <hip/hip_runtime.h>
#include <cstdio>
#include <cstdint>
constexpr int WAVETAB_OFF = 131072 + 320 + 128;
__device__ __forceinline__ int tidx() {
    extern __shared__ __attribute__((aligned(16))) unsigned char lds_tab_[];
    const unsigned hw = __builtin_amdgcn_s_getreg(0x2804);
    const int w = *(volatile __attribute__((address_space(3))) int*)((__attribute__((address_space(3))) unsigned char*)lds_tab_ + WAVETAB_OFF + 4 * hw);
    int l; asm volatile("v_mbcnt_lo_u32_b32 %0, -1, 0\n\tv_mbcnt_hi_u32_b32 %0, -1, %0" : "=v"(l));
    return (__builtin_amdgcn_readfirstlane(w) << 6) | l;
}
#ifndef PG8_WGM
#define PG8_WGM 4
#endif
namespace pg8 {
#define PG8_LAS __attribute__((address_space(3)))
typedef unsigned short bf16_t;
typedef short bf16x8 __attribute__((ext_vector_type(8)));
typedef float f32x4 __attribute__((ext_vector_type(4)));
typedef unsigned u32x4 __attribute__((ext_vector_type(4)));
constexpr int BM = 256, BK = 64, HALF = 128, HTB = HALF * BK * 2  , STAGE_BYTES = 8 * HTB, NXCD = 8, WGM = PG8_WGM;

__host__ __device__ __forceinline__ int lds_byte(int r, int c) { const int st = (r >> 4) * 2 + (c >> 5), rr = r & 15, cc = c & 31, ob = rr * 64 + cc * 2; return st * 1024 + (ob ^ (((ob >> 9) & 1) << 5)); }
__host__ __device__ __forceinline__ void stage_rc(int b, int& R, int& C) { const int st = b / 1024, sb = b % 1024, swz = sb ^ (((sb >> 9) & 1) << 5); R = (st >> 1) * 16 + swz / 64; C = (st & 1) * 32 + (swz % 64) / 2; }
__host__ __device__ __forceinline__ int perm32(int rho) { const int n = rho >> 4, i = rho & 15; return 8 * (i >> 2) + 4 * n + (i & 3); }

struct Unit { int pm, pn; };
struct Gemm { const bf16_t* A; const bf16_t* Bt; int M, N, K; };

struct StaticOrder {
    int nM, nN, nwg, G, c;
    __host__ __device__ void init(int M, int N, int G_, int c_) { nM = M / BM; nN = N / BM; nwg = nM * nN; G = G_; c = c_; }
    __host__ __device__ bool next(int i, Unit& u) const {
        const long L = (long)i * G + c; if (L >= nwg) return false;
        int wgid = (int)L; { const int q = nwg / NXCD, r = nwg % NXCD, xcd = wgid % NXCD, off = wgid / NXCD; wgid = (xcd < r ? xcd * (q + 1) : r * (q + 1) + (xcd - r) * q) + off; }
        const int nig = WGM * nN, gid = wgid / nig, fm = gid * WGM, gsz = (nM - fm) < WGM ? (nM - fm) : WGM;
        u.pm = fm + ((wgid % nig) % gsz); u.pn = (wgid % nig) / gsz; return true;
    }
    __device__ __forceinline__ void a_ready(const Unit&) const {}
    __device__ __forceinline__ void done(const Unit&) const {}
};

typedef float f32x2_t __attribute__((ext_vector_type(2))); typedef __bf16 bf16x2_t __attribute__((ext_vector_type(2)));
__device__ __forceinline__ unsigned cvt_pk_bf16(float lo, float hi) { f32x2_t v = {lo, hi}; bf16x2_t b = __builtin_convertvector(v, bf16x2_t); return __builtin_bit_cast(unsigned, b); }
__device__ __forceinline__ u32x4 pack8(const f32x4 v0, const f32x4 v1) { u32x4 w; w.x = cvt_pk_bf16(v0[0], v0[1]); w.y = cvt_pk_bf16(v0[2], v0[3]); w.z = cvt_pk_bf16(v1[0], v1[1]); w.w = cvt_pk_bf16(v1[2], v1[3]); return w; }
__device__ __forceinline__ float bf_lo(unsigned w) { return __uint_as_float(w << 16); }
__device__ __forceinline__ float bf_hi(unsigned w) { return __uint_as_float(w & 0xffff0000u); }
__device__ __forceinline__ float sigmoid_f(float x) { return __builtin_amdgcn_rcpf(1.0f + __builtin_amdgcn_exp2f(-1.4426950408889634f * x)); }

struct EpiPlain {
    static constexpr bool PERM = true, AFTER_DRAIN = false, PREF = false;
    bf16_t* O; int ldc;
    __device__ __forceinline__ void operator()(const f32x4 (&acc)[2][2][4][2], const Unit& u, int wr, int wc, int fr, int fq) const {
        const int row0 = u.pm * BM + wr * 64 + fr, col0 = u.pn * BM + wc * 32 + 8 * fq;
#pragma unroll
        for (int ai = 0; ai < 2; ++ai)
#pragma unroll
            for (int m = 0; m < 4; ++m) { bf16_t* rowp = O + (size_t)(row0 + ai * HALF + m * 16) * ldc + col0;
#pragma unroll
                for (int bj = 0; bj < 2; ++bj) *(u32x4*)(rowp + bj * HALF) = pack8(acc[ai][bj][m][0], acc[ai][bj][m][1]); }
    }
};
struct EpiSwiGLU {
    static constexpr bool PERM = true, AFTER_DRAIN = false, PREF = true;
    bf16_t* O; int ldc; const float* rs;
    __device__ __forceinline__ const float* pref_src(const Unit& u) const { return rs + u.pm * BM; }
    __device__ __forceinline__ void operator()(const f32x4 (&acc)[2][2][4][2], const Unit& u, int wr, int wc, int fr, int fq, const PG8_LAS float* rslot) const {
        const int row0 = u.pm * BM + wr * 64 + fr, col0 = u.pn * HALF + wc * 32 + 8 * fq;
        float rr[8];
#pragma unroll
        for (int it = 0; it < 8; ++it) rr[it] = rslot[wr * 64 + fr + (it >> 2) * HALF + (it & 3) * 16];
#pragma unroll
        for (int ai = 0; ai < 2; ++ai)
#pragma unroll
            for (int m = 0; m < 4; ++m) { bf16_t* rowp = O + (size_t)(row0 + ai * HALF + m * 16) * ldc + col0;
                f32x4 v[2]; const float r = rr[ai * 4 + m];
#pragma unroll
                for (int n = 0; n < 2; ++n)
#pragma unroll
                    for (int i = 0; i < 4; ++i) { const float g = acc[ai][0][m][n][i] * r, up = acc[ai][1][m][n][i] * r; v[n][i] = g * sigmoid_f(g) * up; }
                *(u32x4*)rowp = pack8(v[0], v[1]); }
    }
};
constexpr int ACT8_LD = 5632; constexpr float ACT8_SCALE = 8.f, W8_SCALE = 1024.f;
typedef unsigned u32x2 __attribute__((ext_vector_type(2)));
__device__ __forceinline__ unsigned pk4_fp8(float a, float b, float c, float d) {
    int w = __builtin_amdgcn_cvt_pk_fp8_f32(__builtin_amdgcn_fmed3f(a, -448.f, 448.f), __builtin_amdgcn_fmed3f(b, -448.f, 448.f), 0, false);
    w = __builtin_amdgcn_cvt_pk_fp8_f32(__builtin_amdgcn_fmed3f(c, -448.f, 448.f), __builtin_amdgcn_fmed3f(d, -448.f, 448.f), w, true); return (unsigned)w; }
struct EpiSwiGLU8 {
    static constexpr bool PERM = true, AFTER_DRAIN = false, PREF = true;
    unsigned char* O; const float* rs;
    __device__ __forceinline__ const float* pref_src(const Unit& u) const { return rs + u.pm * BM; }
    __device__ __forceinline__ void operator()(const f32x4 (&acc)[2][2][4][2], const Unit& u, int wr, int wc, int fr, int fq, const PG8_LAS float* rslot) const {
        const int row0 = u.pm * BM + wr * 64 + fr, col0 = u.pn * HALF + wc * 32 + 8 * fq;
        float rr[8];
#pragma unroll
        for (int it = 0; it < 8; ++it) rr[it] = rslot[wr * 64 + fr + (it >> 2) * HALF + (it & 3) * 16];
#pragma unroll
        for (int ai = 0; ai < 2; ++ai)
#pragma unroll
            for (int m = 0; m < 4; ++m) { unsigned char* rowp = O + (size_t)(row0 + ai * HALF + m * 16) * ACT8_LD + col0;
                f32x4 v[2]; const float r = rr[ai * 4 + m];
#pragma unroll
                for (int n = 0; n < 2; ++n)
#pragma unroll
                    for (int i = 0; i < 4; ++i) { const float g = acc[ai][0][m][n][i] * r, up = acc[ai][1][m][n][i] * r; v[n][i] = g * sigmoid_f(g) * up * ACT8_SCALE; }
                u32x2 w; w.x = pk4_fp8(v[0][0], v[0][1], v[0][2], v[0][3]); w.y = pk4_fp8(v[1][0], v[1][1], v[1][2], v[1][3]);
                *(u32x2*)rowp = w;
                if (u.pn == (5504 / HALF) - 1) *(u32x2*)(rowp + HALF) = (u32x2){0u, 0u}; }
    }
};
struct EpiPlainS {
    static constexpr bool PERM = true, AFTER_DRAIN = false, PREF = false;
    bf16_t* O; int ldc; float sc;
    __device__ __forceinline__ void operator()(const f32x4 (&acc)[2][2][4][2], const Unit& u, int wr, int wc, int fr, int fq) const {
        const int row0 = u.pm * BM + wr * 64 + fr, col0 = u.pn * BM + wc * 32 + 8 * fq;
#pragma unroll
        for (int ai = 0; ai < 2; ++ai)
#pragma unroll
            for (int m = 0; m < 4; ++m) { bf16_t* rowp = O + (size_t)(row0 + ai * HALF + m * 16) * ldc + col0;
#pragma unroll
                for (int bj = 0; bj < 2; ++bj) *(u32x4*)(rowp + bj * HALF) = pack8(acc[ai][bj][m][0] * sc, acc[ai][bj][m][1] * sc); }
    }
};
struct EpiWin {
    static constexpr bool PERM = true, AFTER_DRAIN = false, PREF = true;
    bf16_t *QA, *KA, *VA, *QB, *KB, *VB, *SGA, *SGB;
    float *okA_p, *ovA_p, *okB_p, *ovB_p, *okA_s, *ovA_s, *okB_s, *ovB_s;
    float cqa, cqb; const float* rs;
    __device__ __forceinline__ const float* pref_src(const Unit& u) const { return rs + u.pm * BM; }
    __device__ __forceinline__ void operator()(const f32x4 (&acc)[2][2][4][2], const Unit& u, int wr, int wc, int fr, int fq, const PG8_LAS float* rslot) const {
        const int pn = u.pn;
        int seg, ct; if (pn < 24) { seg = pn >> 2; ct = pn & 3; } else if (pn < 32) { seg = 6; ct = pn - 24; } else { seg = 7; ct = pn - 32; }
        const bool prompt = u.pm < 128;
        const int row0 = u.pm * BM + wr * 64 + fr, col0 = ct * BM + wc * 32 + 8 * fq;
        bf16_t* bdst; float* fdst = nullptr; int ld = 1024; float scale = 1.f;
        switch (seg) {
            case 0: bdst = QA; scale = cqa; break;
            case 1: bdst = KA; fdst = prompt ? okA_p : okA_s; break;
            case 2: bdst = VA; fdst = prompt ? ovA_p : ovA_s; break;
            case 3: bdst = QB; scale = cqb; break;
            case 4: bdst = KB; fdst = prompt ? okB_p : okB_s; break;
            case 5: bdst = VB; fdst = prompt ? ovB_p : ovB_s; break;
            case 6: bdst = SGA; ld = 2048; break;
            default: bdst = SGB; ld = 2048; break;
        }
        const bool dorope = (seg <= 1) && ((wc & 1) == 0);
        const bool gate = seg >= 6;
        const float sgn = (fq == 0) ? -1.f : 1.f;
        float rr[8];
#pragma unroll
        for (int it = 0; it < 8; ++it) rr[it] = rslot[wr * 64 + fr + (it >> 2) * HALF + (it & 3) * 16];
#pragma unroll
        for (int ai = 0; ai < 2; ++ai)
#pragma unroll
            for (int m = 0; m < 4; ++m) {
                const int row = row0 + ai * HALF + m * 16; const float r = rr[ai * 4 + m];
                f32x4 v[2][2];
#pragma unroll
                for (int bj = 0; bj < 2; ++bj) { v[bj][0] = acc[ai][bj][m][0] * r; v[bj][1] = acc[ai][bj][m][1] * r; }
                if (dorope) {
                    const float posf = (float)(prompt ? (row & 8191) : (1024 + (row & 63)));
                    constexpr float RC[8] = {0.15915494309189535f, 0.030863763775294327f, 0.0059851855051852755f, 0.0011606636683911752f, 0.00022507907903927652f, 4.364795314162585e-05f, 8.464330686203427e-06f, 1.6414263642582245e-06f};
                    f32x4 c0, c1, s0, s1;
#pragma unroll
                    for (int i = 0; i < 4; ++i) { const float r0 = __builtin_amdgcn_fractf(posf * RC[i]), r1 = __builtin_amdgcn_fractf(posf * RC[4 + i]);
                        c0[i] = __builtin_amdgcn_cosf(r0); s0[i] = __builtin_amdgcn_sinf(r0); c1[i] = __builtin_amdgcn_cosf(r1); s1[i] = __builtin_amdgcn_sinf(r1); }
#pragma unroll
                    for (int bj = 0; bj < 2; ++bj)
#pragma unroll
                        for (int i = 0; i < 4; ++i) {
                            const float a0 = v[bj][0][i], a1 = v[bj][1][i];
                            const float p0 = __shfl_xor(a0, 16), p1 = __shfl_xor(a1, 16);
                            const float r0 = a0 * c0[i] + sgn * p0 * s0[i], r1 = a1 * c1[i] + sgn * p1 * s1[i];
                            if (fq < 2) { v[bj][0][i] = r0; v[bj][1][i] = r1; }
                        }
                }
                if (fdst) { float* fp = fdst + (size_t)(prompt ? row : row - 32768) * 1024 + col0;
#pragma unroll
                    for (int bj = 0; bj < 2; ++bj) { __builtin_nontemporal_store(v[bj][0], (f32x4*)(fp + bj * HALF)); __builtin_nontemporal_store(v[bj][1], (f32x4*)(fp + bj * HALF + 4)); } }
                bf16_t* bp = bdst + (size_t)row * ld + col0;
#pragma unroll
                for (int bj = 0; bj < 2; ++bj) {
                    f32x4 a = v[bj][0], b = v[bj][1];
                    if (gate) {
#pragma unroll
                        for (int i = 0; i < 4; ++i) { a[i] = sigmoid_f(a[i]); b[i] = sigmoid_f(b[i]); }
                    } else { a = a * scale; b = b * scale; }
                    *(u32x4*)(bp + bj * HALF) = pack8(a, b);
                }
            }
    }
};
struct EpiUpGate {
    static constexpr bool PERM = true, AFTER_DRAIN = false, PREF = false;
    const bf16_t *SGA, *SGB; bf16_t* MG;
    __device__ __forceinline__ void operator()(const f32x4 (&acc)[2][2][4][2], const Unit& u, int wr, int wc, int fr, int fq) const {
        const bool br = u.pm >= 136; const int pm = br ? u.pm - 136 : u.pm, pn = br ? u.pn - 8 : u.pn;
        const bf16_t* sg = br ? SGB : SGA;
        const int row0 = pm * BM + wr * 64 + fr, col0 = pn * BM + wc * 32 + 8 * fq;
        u32x4 gq[4][2], pq[4][2];
#define UG_LOAD(G_, P_, it_) do { const size_t off_ = (size_t)(row0 + ((it_) >> 2) * HALF + ((it_) & 3) * 16) * 2048 + col0; \
            G_[0] = *(const u32x4*)(sg + off_); G_[1] = *(const u32x4*)(sg + off_ + HALF); \
            if (br) { P_[0] = *(const u32x4*)(MG + off_); P_[1] = *(const u32x4*)(MG + off_ + HALF); } } while (0)
#pragma unroll
        for (int j = 0; j < 4; ++j) UG_LOAD(gq[j], pq[j], j);
#pragma unroll
        for (int it = 0; it < 8; ++it) { const int ai = it >> 2, m = it & 3;
            const size_t off = (size_t)(row0 + ai * HALF + m * 16) * 2048 + col0;
            u32x4 outw[2];
#pragma unroll
            for (int bj = 0; bj < 2; ++bj) {
                const u32x4 g = gq[m][bj];
                f32x4 a = acc[ai][bj][m][0], b = acc[ai][bj][m][1];
                a[0] *= bf_lo(g.x); a[1] *= bf_hi(g.x); a[2] *= bf_lo(g.y); a[3] *= bf_hi(g.y);
                b[0] *= bf_lo(g.z); b[1] *= bf_hi(g.z); b[2] *= bf_lo(g.w); b[3] *= bf_hi(g.w);
                if (br) { const u32x4 p = pq[m][bj];
                    a[0] += bf_lo(p.x); a[1] += bf_hi(p.x); a[2] += bf_lo(p.y); a[3] += bf_hi(p.y);
                    b[0] += bf_lo(p.z); b[1] += bf_hi(p.z); b[2] += bf_lo(p.w); b[3] += bf_hi(p.w); }
                outw[bj] = pack8(a, b);
            }
            if (it < 4) UG_LOAD(gq[m], pq[m], it + 4);
            *(u32x4*)(MG + off) = outw[0]; *(u32x4*)(MG + off + HALF) = outw[1]; }
#undef UG_LOAD
    }
};
struct UpOrder {
    StaticOrder so;
    __device__ void init(int G_, int c_) { so.init(136 * BM, 8 * BM, G_, c_); }
    __device__ bool next(int i, Unit& u) const { if (!so.next(i >> 1, u)) return false; if (i & 1) { u.pm += 136; u.pn += 8; } return true; }
    __device__ __forceinline__ void a_ready(const Unit&) const {}
    __device__ __forceinline__ void done(const Unit&) const {}
};

struct SampleOrder {
    int nN, n, c;
    __device__ bool next(int i, Unit& u) const { const int L = i * n + c; if (L >= 8 * nN) return false; u.pm = 128 + (L & 7); u.pn = L >> 3; return true; }
    __device__ __forceinline__ void a_ready(const Unit&) const {}
    __device__ __forceinline__ void done(const Unit&) const {}
};

typedef int i32x4_t __attribute__((ext_vector_type(4))); typedef int i32x8_t __attribute__((ext_vector_type(8)));
__device__ __forceinline__ f32x4 mfma_f8(const bf16x8 (&b)[2], const bf16x8 (&a)[2], f32x4 c) {
    const i32x8_t B = __builtin_shufflevector(__builtin_bit_cast(i32x4_t, b[0]), __builtin_bit_cast(i32x4_t, b[1]), 0, 1, 2, 3, 4, 5, 6, 7);
    const i32x8_t A = __builtin_shufflevector(__builtin_bit_cast(i32x4_t, a[0]), __builtin_bit_cast(i32x4_t, a[1]), 0, 1, 2, 3, 4, 5, 6, 7);
    asm volatile("v_mfma_f32_16x16x128_f8f6f4 %0, %1, %2, %0" : "+v"(c) : "v"(B), "v"(A));
    return c;
}
template <class Epi, class Sched, bool ALIGN_EPI = false, bool SP2 = false, bool F8 = false>
__device__ __forceinline__ void gemm_phase(PG8_LAS unsigned char* lds, const Gemm g, const Sched& S, const Epi& E) {
    int tid_ = tidx(); asm volatile("" : "+v"(tid_));
    const int tid = tid_, wid = __builtin_amdgcn_readfirstlane(tid >> 6), lane = tid & 63, wr = wid >> 2, wc = wid & 3, fr = lane & 15, fq = lane >> 4;
    const int K = g.K, nt = K / BK;
    unsigned voffA[2], voffB[2];
#pragma unroll
    for (int i = 0; i < 2; ++i) { int R, C; stage_rc(tid * 16 + i * 8192, R, C); const int Rb = Epi::PERM ? ((R & ~31) + perm32(R & 31)) : R;
        voffA[i] = (unsigned)(R * K + C) * 2u; voffB[i] = (unsigned)(Rb * K + C) * 2u; }
    const size_t kstep = (size_t)(BK * 2);
    const size_t hstep = (size_t)HALF * K * 2;
    const size_t tstep = 2 * hstep;
    const unsigned ldsw = (unsigned)wid * 1024u;
    const int aoff = lds_byte(wr * 64 + fr, fq * 8), boff = lds_byte(wc * 32 + fr, fq * 8);
    unsigned bb_ = (unsigned)(uintptr_t)lds + 4u * HTB + (unsigned)boff; asm volatile("" : "+v"(bb_)); const PG8_LAS unsigned char* const ldsb = (const PG8_LAS unsigned char*)(uintptr_t)bb_;
#define PG8_SA(b, h) (((b) * 2 + (h)) * HTB)
#define PG8_SB(b, h) ((4 + (b) * 2 + (h)) * HTB)
#define PG8_STAGE(bufoff, gbase, voff) do { _Pragma("unroll") for (int _i = 0; _i < 2; ++_i) \
        asm volatile("s_mov_b32 m0, %2\n\ts_nop 0\n\tglobal_load_lds_dwordx4 %0, %1" :: "v"((voff)[_i]), "s"((const char*)(gbase)), \
                     "s"((unsigned)(uintptr_t)(lds + (bufoff) + ldsw + _i * 8192)) : "memory"); } while (0)
#define PG8_LDA(dst, b, h) do { _Pragma("unroll") for (int m = 0; m < 4; ++m) _Pragma("unroll") for (int k = 0; k < 2; ++k) dst[m][k] = *(const PG8_LAS bf16x8*)(lds + PG8_SA(b, h) + aoff + m * 2048 + k * 1024); } while (0)
#define PG8_LDB(dst, b, h) do { _Pragma("unroll") for (int n = 0; n < 2; ++n) _Pragma("unroll") for (int k = 0; k < 2; ++k) dst[n][k] = *(const PG8_LAS bf16x8*)(ldsb + ((b) * 2 + (h)) * HTB + n * 2048 + k * 1024); } while (0)
#define PG8_MMA(ai, bj, At, Bt) do { __builtin_amdgcn_s_setprio(1); _Pragma("unroll") for (int m = 0; m < 4; ++m) _Pragma("unroll") for (int n = 0; n < 2; ++n) { \
        if constexpr (F8) acc[ai][bj][m][n] = mfma_f8(Bt[n], At[m], acc[ai][bj][m][n]); \
        else { _Pragma("unroll") for (int k = 0; k < 2; ++k) acc[ai][bj][m][n] = __builtin_amdgcn_mfma_f32_16x16x32_bf16(Bt[n][k], At[m][k], acc[ai][bj][m][n], 0, 0, 0); } } \
        if constexpr (F8) asm volatile("s_nop 7"); __builtin_amdgcn_s_setprio(0); } while (0)
#define PG8_WAIT_V(n) asm volatile("s_waitcnt vmcnt(" #n ")" ::: "memory")
#define PG8_WAIT_L(n) asm volatile("s_waitcnt lgkmcnt(" #n ")" ::: "memory")
#define PG8_WAIT_VL(n) asm volatile("s_waitcnt vmcnt(" #n ") lgkmcnt(0)" ::: "memory")
#define PG8_BAR __builtin_amdgcn_s_barrier()
#define PG8_SCHED __builtin_amdgcn_sched_barrier(0)
    Unit cur, nxt; int ui = 0;
    if (!S.next(0, cur)) return;
    f32x4 acc[2][2][4][2];
#pragma unroll
    for (int a = 0; a < 2; ++a)
#pragma unroll
        for (int b = 0; b < 2; ++b)
#pragma unroll
            for (int m = 0; m < 4; ++m)
#pragma unroll
                for (int n = 0; n < 2; ++n) acc[a][b][m][n] = (f32x4){0.f, 0.f, 0.f, 0.f};
    bf16x8 At[4][2], B0[2][2], B1[2][2];
    const char* cA = (const char*)g.A + (size_t)cur.pm * tstep; const char* cB = (const char*)g.Bt + (size_t)cur.pn * tstep;
    S.a_ready(cur);
    constexpr int RS_SLOT = 134208;
#define PG8_RSDMA(u_, par_) do { if constexpr (Epi::PREF) { if (wid == 0) __builtin_amdgcn_global_load_lds((const unsigned*)(E.pref_src(u_) + lane * 4), (PG8_LAS unsigned*)(lds + RS_SLOT + (par_) * 1024), 16, 0, 0); } } while (0)
    PG8_RSDMA(cur, 0);
    if constexpr (SP2) {
        PG8_STAGE(PG8_SB(0, 0), cB, voffB); PG8_STAGE(PG8_SB(0, 1), cB + hstep, voffB); PG8_STAGE(PG8_SA(0, 0), cA, voffA); PG8_STAGE(PG8_SA(0, 1), cA + hstep, voffA);
        if (wr == 1) PG8_BAR;
        PG8_WAIT_V(2); PG8_BAR;
        PG8_STAGE(PG8_SB(1, 0), cB + kstep, voffB); PG8_STAGE(PG8_SA(1, 0), cA + kstep, voffA); PG8_STAGE(PG8_SB(1, 1), cB + hstep + kstep, voffB);
        PG8_WAIT_V(6); PG8_BAR;
    } else {
        PG8_STAGE(PG8_SB(0, 0), cB, voffB); PG8_STAGE(PG8_SA(0, 0), cA, voffA); PG8_STAGE(PG8_SB(0, 1), cB + hstep, voffB); PG8_STAGE(PG8_SA(0, 1), cA + hstep, voffA);
        if (wr == 1) PG8_BAR;
        PG8_WAIT_V(4); PG8_BAR;
        PG8_STAGE(PG8_SB(1, 0), cB + kstep, voffB); PG8_STAGE(PG8_SA(1, 0), cA + kstep, voffA); PG8_STAGE(PG8_SB(1, 1), cB + hstep + kstep, voffB);
        PG8_WAIT_V(6); PG8_BAR;
    }
    for (;;) {
        const bool has_next = S.next(ui + 1, nxt);
        const char* nA = has_next ? (const char*)g.A + (size_t)nxt.pm * tstep : cA; const char* nB = has_next ? (const char*)g.Bt + (size_t)nxt.pn * tstep : cB;
        for (int t = 0; t < nt; t += 2) {
            const bool last = (t == nt - 2);
            const char* a1 = cA + (size_t)(t + 1) * kstep;
            const char* a2 = last ? nA : cA + (size_t)(t + 2) * kstep; const char* b2 = last ? nB : cB + (size_t)(t + 2) * kstep;
            const char* a3 = a2 + kstep; const char* b3 = b2 + kstep;
            if (last && has_next) { S.a_ready(nxt); PG8_RSDMA(nxt, (ui + 1) & 1); }
            if constexpr (SP2) {
            PG8_LDB(B0, 0, 0); PG8_LDB(B1, 0, 1); PG8_SCHED; PG8_LDA(At, 0, 0); PG8_STAGE(PG8_SA(1, 1), a1 + hstep, voffA);
            PG8_WAIT_VL(8); PG8_BAR; PG8_MMA(0, 0, At, B0); PG8_MMA(0, 1, At, B1); PG8_BAR; PG8_SCHED;
            PG8_LDA(At, 0, 1); PG8_STAGE(PG8_SB(0, 0), b2, voffB); PG8_STAGE(PG8_SB(0, 1), b2 + hstep, voffB); PG8_STAGE(PG8_SA(0, 0), a2, voffA);
            PG8_WAIT_VL(8); PG8_BAR; PG8_MMA(1, 0, At, B0); PG8_MMA(1, 1, At, B1); PG8_BAR; PG8_SCHED;
            PG8_LDB(B0, 1, 0); PG8_LDB(B1, 1, 1); PG8_SCHED; PG8_LDA(At, 1, 0); PG8_STAGE(PG8_SA(0, 1), a2 + hstep, voffA);
            PG8_WAIT_VL(8); PG8_BAR; PG8_MMA(0, 0, At, B0); PG8_MMA(0, 1, At, B1); PG8_BAR; PG8_SCHED;
            PG8_LDA(At, 1, 1); PG8_STAGE(PG8_SB(1, 0), b3, voffB); PG8_STAGE(PG8_SB(1, 1), b3 + hstep, voffB); PG8_STAGE(PG8_SA(1, 0), a3, voffA);
            PG8_WAIT_VL(8); PG8_BAR; PG8_MMA(1, 0, At, B0); PG8_MMA(1, 1, At, B1); PG8_BAR; PG8_SCHED;
            } else {
            PG8_LDB(B0, 0, 0); PG8_SCHED; PG8_LDA(At, 0, 0); PG8_STAGE(PG8_SA(1, 1), a1 + hstep, voffA);
            PG8_WAIT_L(8); PG8_BAR; PG8_WAIT_L(0); PG8_MMA(0, 0, At, B0); PG8_BAR; PG8_SCHED;
            PG8_LDB(B1, 0, 1); PG8_STAGE(PG8_SB(0, 0), b2, voffB);
            PG8_BAR; PG8_WAIT_L(0); PG8_MMA(0, 1, At, B1); PG8_BAR;
            PG8_LDA(At, 0, 1); PG8_STAGE(PG8_SA(0, 0), a2, voffA);
            PG8_BAR; PG8_WAIT_L(0); PG8_MMA(1, 0, At, B0); PG8_BAR; PG8_SCHED;
            PG8_STAGE(PG8_SB(0, 1), b2 + hstep, voffB);
            PG8_WAIT_V(6); PG8_BAR; PG8_MMA(1, 1, At, B1); PG8_BAR;
            PG8_LDB(B0, 1, 0); PG8_SCHED; PG8_LDA(At, 1, 0); PG8_STAGE(PG8_SA(0, 1), a2 + hstep, voffA);
            PG8_WAIT_L(8); PG8_BAR; PG8_WAIT_L(0); PG8_MMA(0, 0, At, B0); PG8_BAR; PG8_SCHED;
            PG8_LDB(B1, 1, 1); PG8_STAGE(PG8_SB(1, 0), b3, voffB);
            PG8_BAR; PG8_WAIT_L(0); PG8_MMA(0, 1, At, B1); PG8_BAR;
            PG8_LDA(At, 1, 1); PG8_STAGE(PG8_SA(1, 0), a3, voffA);
            PG8_BAR; PG8_WAIT_L(0); PG8_MMA(1, 0, At, B0); PG8_BAR; PG8_SCHED;
            PG8_STAGE(PG8_SB(1, 1), b3 + hstep, voffB);
            PG8_WAIT_V(6); PG8_BAR; PG8_MMA(1, 1, At, B1); PG8_BAR;
            }
        }
        if constexpr (F8) asm volatile("s_nop 15\n\ts_nop 15" ::: "memory");
        if constexpr (ALIGN_EPI) { if (wr == 0) PG8_BAR; }
        if constexpr (!Epi::AFTER_DRAIN) {
            if constexpr (Epi::PREF) E(acc, cur, wr, wc, fr, fq, (const PG8_LAS float*)(lds + RS_SLOT + (ui & 1) * 1024)); else E(acc, cur, wr, wc, fr, fq);
            S.done(cur); }
        if (!has_next) break;
#pragma unroll
        for (int a = 0; a < 2; ++a)
#pragma unroll
            for (int b = 0; b < 2; ++b)
#pragma unroll
                for (int m = 0; m < 4; ++m)
#pragma unroll
                    for (int n = 0; n < 2; ++n) acc[a][b][m][n] = (f32x4){0.f, 0.f, 0.f, 0.f};
        cur = nxt; cA = nA; cB = nB; ++ui;
        if constexpr (ALIGN_EPI) { if (wr == 1) PG8_BAR; }
    }
    PG8_WAIT_V(0);
    if constexpr (!ALIGN_EPI) { if (wr == 0) PG8_BAR; }
    PG8_BAR;
    if constexpr (Epi::AFTER_DRAIN) { E.fused(acc, cur, wr, wc, fr, fq, lds, wid, lane); S.done(cur); }
#undef PG8_RSDMA
#undef PG8_SA
#undef PG8_SB
#undef PG8_STAGE
#undef PG8_LDA
#undef PG8_LDB
#undef PG8_MMA
#undef PG8_WAIT_V
#undef PG8_WAIT_L
#undef PG8_WAIT_VL
#undef PG8_BAR
#undef PG8_SCHED
}
}
constexpr int NWAVES = 8;
constexpr int DM = 2048, DFF = 5504, NPROMPT = 4 * 8192, NSAMPLE = 32 * 64, MTOK = NPROMPT + NSAMPLE;
constexpr int INCOLS = 10240, WQA = 1024;
constexpr float EPS = 1e-6f;
constexpr int N_UNITS = 2560;
constexpr size_t MiB = 1u << 20;
constexpr size_t WS_CTL = 0, CTL_ZERO_BYTES = 1 * MiB;
constexpr size_t WS_LAM = 1 * MiB;
constexpr size_t WS_RSTD = 1 * MiB + 4096;
constexpr size_t WS_WIN = 2 * MiB;
constexpr size_t WS_F1GU = WS_WIN + (size_t)INCOLS * DM * 2;
constexpr size_t WS_F1D = WS_F1GU + (size_t)2 * DFF * DM * 2;
constexpr size_t WS_F2GU = WS_F1D + (size_t)DM * DFF * 2;
constexpr size_t WS_F2D = WS_F2GU + (size_t)2 * DFF * DM * 2;
constexpr size_t WS_WAB = WS_F2D + (size_t)DM * DFF * 2;
constexpr size_t WS_WO = WS_WAB + (size_t)4096 * 1024 * 2;
constexpr size_t WS_XN = WS_WO + (size_t)DM * DM * 2;
constexpr size_t WS_D = WS_XN + (size_t)MTOK * DM * 2;
constexpr size_t WS_BIG = WS_D + (size_t)MTOK * DM * 2;
constexpr size_t SZ_HEAD = (size_t)MTOK * 1024 * 2;
constexpr size_t WS_QA = WS_BIG, WS_QB = WS_QA + SZ_HEAD, WS_KA = WS_QB + SZ_HEAD, WS_VA = WS_KA + SZ_HEAD, WS_KB = WS_VA + SZ_HEAD, WS_VB = WS_KB + SZ_HEAD;
constexpr size_t WS_SGA = WS_VB + SZ_HEAD, WS_SGB = WS_SGA + 2 * SZ_HEAD, WS_END = WS_SGB + 2 * SZ_HEAD;
static_assert(WS_BIG + (size_t)MTOK * DFF * 2 <= WS_END, "ACT fits the big region");
static_assert((size_t)256 * 2 * 1088 * 128 * 2 <= (size_t)MTOK * DM * 2 && WS_RSTD + (size_t)MTOK * 4 <= WS_WIN, "the sample units' key/value copies and MERGED fit the (still unused) y region of d_out");
constexpr int CW_TMO = 0, CW_QUEUE = 64, CW_BAR = 4096;

constexpr int RING_OFF = 0, RING_BYTES = 131072;
constexpr int LDSCTL_OFF = RING_BYTES, MISC_OFF = LDSCTL_OFF + 320;
constexpr int LDS_BYTES = 147456;

struct Inputs {
    const float *x_prompt, *x_sample, *cdk, *cdv, *csk, *csv, *w_in, *w_up_a, *w_up_b, *w_o, *lq1, *lk1, *lq2, *lk2, *subln_g;
    const float *n1a, *n1b, *nma, *nmb, *n2a, *n2b, *f1g, *f1u, *f1d, *f2g, *f2u, *f2d;
};
struct Args { Inputs in; float* out; unsigned char* ws; };
typedef const __attribute__((address_space(4))) Args* KArgs;
namespace att {
typedef unsigned short bf16;
using bf16x8 = __attribute__((ext_vector_type(8))) short;
using s16x4  = __attribute__((ext_vector_type(4))) short;
using f32x16 = __attribute__((ext_vector_type(16))) float;
using f32x8  = __attribute__((ext_vector_type(8))) float;
using f32x4  = __attribute__((ext_vector_type(4))) float;
using u32x4  = __attribute__((ext_vector_type(4))) unsigned;
constexpr int NW = 8, QBLK = 32, KVBLK = 64, LD = 1024;
constexpr size_t SHM_V = KVBLK * 128 * 2, SHM_K = KVBLK * 128 * 2, SHM_ATTN = 2 * SHM_V + 2 * SHM_K + NW * 8192;
constexpr size_t OFF_Q = 65536, OFF_WS = 131072 + 1024, OFF_VOTE = OFF_WS + NW * 64 * 4, OFF_DMA = OFF_VOTE + 64;
constexpr float THR2 = 11.0f;
#define KSWZ(row, colB) ((row) * 256 + ((colB) ^ (((row) & 7) << 4)))
#define SBAR() __builtin_amdgcn_sched_barrier(0)
__device__ __forceinline__ int crow(int r, int hi) { return (r & 3) + 8 * (r >> 2) + 4 * hi; }
__device__ __forceinline__ unsigned cvtpk(float lo, float hi) { return pg8::cvt_pk_bf16(lo, hi); }
template <typename TIn> struct Stage;
template <> struct Stage<bf16>  { using T = bf16x8;
  __device__ static __forceinline__ T ld8(const bf16* p) { return *reinterpret_cast<const bf16x8*>(p); }
  __device__ static __forceinline__ bf16x8 tobf(T x) { return x; } };
template <> struct Stage<float> { using T = bf16x8;
  __device__ static __forceinline__ T ld8(const float* p) { const f32x8 x = *reinterpret_cast<const f32x8*>(p);
    u32x4 w = {cvtpk(x[0], x[1]), cvtpk(x[2], x[3]), cvtpk(x[4], x[5]), cvtpk(x[6], x[7])}; return *reinterpret_cast<bf16x8*>(&w); }
  __device__ static __forceinline__ bf16x8 tobf(T x) { return x; } };
struct KVLin { typedef bf16 T; static constexpr int PITCH = LD; const bf16* k0; const bf16* v0;
  __device__ __forceinline__ const bf16* krow(int k) const { return k0 + (size_t)k * LD; }
  __device__ __forceinline__ const bf16* vrow(int k) const { return v0 + (size_t)k * LD; } };
struct KVScr { typedef bf16 T; static constexpr int PITCH = 128; const bf16* k0; const bf16* v0;
  __device__ __forceinline__ const bf16* krow(int k) const { return k0 + (size_t)k * 128; }
  __device__ __forceinline__ const bf16* vrow(int k) const { return v0 + (size_t)k * 128; } };
struct KVTwo { typedef float T; const float* k0; const float* v0; const float* k1; const float* v1; int n0;
  __device__ __forceinline__ const float* krow(int k) const { return k < n0 ? k0 + (size_t)k * LD : k1 + (size_t)((k - n0) & 63) * LD; }
  __device__ __forceinline__ const float* vrow(int k) const { return k < n0 ? v0 + (size_t)k * LD : v1 + (size_t)((k - n0) & 63) * LD; } };

#define PK4(P, BASE, OUT) do { u32x4 w = {cvtpk(P[BASE + 0], P[BASE + 1]), cvtpk(P[BASE + 2], P[BASE + 3]), cvtpk(P[BASE + 4], P[BASE + 5]), cvtpk(P[BASE + 6], P[BASE + 7])}; \
    OUT = __builtin_bit_cast(bf16x8, w); } while (0)

__device__ __forceinline__ void partialSM(f32x16& p0, f32x16& p1, float& m_reg, float& alpha) {
  float pmax;
  { float a = __builtin_fmaxf(__builtin_fmaxf(p0[0], p0[1]), p0[2]), b = __builtin_fmaxf(__builtin_fmaxf(p0[3], p0[4]), p0[5]), c = __builtin_fmaxf(__builtin_fmaxf(p1[0], p1[1]), p1[2]), d = __builtin_fmaxf(__builtin_fmaxf(p1[3], p1[4]), p1[5]);
    a = __builtin_fmaxf(__builtin_fmaxf(a, p0[6]), p0[7]); b = __builtin_fmaxf(__builtin_fmaxf(b, p0[8]), p0[9]); c = __builtin_fmaxf(__builtin_fmaxf(c, p1[6]), p1[7]); d = __builtin_fmaxf(__builtin_fmaxf(d, p1[8]), p1[9]);
    a = __builtin_fmaxf(__builtin_fmaxf(a, p0[10]), p0[11]); b = __builtin_fmaxf(__builtin_fmaxf(b, p0[12]), p0[13]); c = __builtin_fmaxf(__builtin_fmaxf(c, p1[10]), p1[11]); d = __builtin_fmaxf(__builtin_fmaxf(d, p1[12]), p1[13]);
    a = __builtin_fmaxf(__builtin_fmaxf(a, p0[14]), p0[15]); c = __builtin_fmaxf(__builtin_fmaxf(c, p1[14]), p1[15]);
    pmax = __builtin_fmaxf(__builtin_fmaxf(a, b), __builtin_fmaxf(c, d)); }
  { auto rr = __builtin_amdgcn_permlane32_swap(__float_as_uint(pmax), __float_as_uint(pmax), false, false);
    pmax = fmaxf(__uint_as_float(rr[0]), __uint_as_float(rr[1])); }
  float mn;
  if (__builtin_expect(__all(pmax - m_reg <= THR2), 1)) { mn = m_reg; alpha = 1.f; }
  else { mn = fmaxf(m_reg, pmax); alpha = __builtin_amdgcn_exp2f(m_reg - mn); m_reg = mn; }
#pragma unroll
  for (int r = 0; r < 16; ++r) p0[r] = p0[r] - mn;
#pragma unroll
  for (int r = 0; r < 16; ++r) p1[r] = p1[r] - mn;
#pragma unroll
  for (int r = 0; r < 16; ++r) p0[r] = __builtin_amdgcn_exp2f(p0[r]);
}
__device__ __forceinline__ void finishSM(f32x16& p0, f32x16& p1, float alpha, float& l_reg, bf16x8& pa0, bf16x8& pa1, bf16x8& pa2, bf16x8& pa3) {
#pragma unroll
  for (int r = 0; r < 16; ++r) p1[r] = __builtin_amdgcn_exp2f(p1[r]);
  float ps;
  { float a = p0[0] + p0[1], b = p0[2] + p0[3], c = p1[0] + p1[1], d = p1[2] + p1[3];
#pragma unroll
    for (int r = 4; r < 16; r += 4) { a += p0[r]; a += p0[r + 1]; b += p0[r + 2]; b += p0[r + 3]; c += p1[r]; c += p1[r + 1]; d += p1[r + 2]; d += p1[r + 3]; }
    ps = (a + b) + (c + d); }
  { auto rr = __builtin_amdgcn_permlane32_swap(__float_as_uint(ps), __float_as_uint(ps), false, false);
    ps = __uint_as_float(rr[0]) + __uint_as_float(rr[1]); }
  l_reg = l_reg * alpha + ps;
  PK4(p0, 0, pa0); PK4(p0, 8, pa1); PK4(p1, 0, pa2); PK4(p1, 8, pa3);
}
__device__ __forceinline__ float rowsum32(const f32x16& p0, const f32x16& p1) {
  float a = p0[0] + p0[1], b = p0[2] + p0[3], c = p1[0] + p1[1], d = p1[2] + p1[3];
#pragma unroll
  for (int r = 4; r < 16; r += 4) { a += p0[r]; a += p0[r + 1]; b += p0[r + 2]; b += p0[r + 3]; c += p1[r]; c += p1[r + 1]; d += p1[r + 2]; d += p1[r + 3]; }
  const float ps = (a + b) + (c + d);
  auto rr = __builtin_amdgcn_permlane32_swap(__float_as_uint(ps), __float_as_uint(ps), false, false);
  return __uint_as_float(rr[0]) + __uint_as_float(rr[1]);
}
__device__ __forceinline__ float rowmax32(const f32x16& p0, const f32x16& p1) {
  float a = __builtin_fmaxf(__builtin_fmaxf(p0[0], p0[1]), p0[2]), b = __builtin_fmaxf(__builtin_fmaxf(p0[3], p0[4]), p0[5]), c = __builtin_fmaxf(__builtin_fmaxf(p1[0], p1[1]), p1[2]), d = __builtin_fmaxf(__builtin_fmaxf(p1[3], p1[4]), p1[5]);
  a = __builtin_fmaxf(__builtin_fmaxf(a, p0[6]), p0[7]); b = __builtin_fmaxf(__builtin_fmaxf(b, p0[8]), p0[9]); c = __builtin_fmaxf(__builtin_fmaxf(c, p1[6]), p1[7]); d = __builtin_fmaxf(__builtin_fmaxf(d, p1[8]), p1[9]);
  a = __builtin_fmaxf(__builtin_fmaxf(a, p0[10]), p0[11]); b = __builtin_fmaxf(__builtin_fmaxf(b, p0[12]), p0[13]); c = __builtin_fmaxf(__builtin_fmaxf(c, p1[10]), p1[11]); d = __builtin_fmaxf(__builtin_fmaxf(d, p1[12]), p1[13]);
  a = __builtin_fmaxf(__builtin_fmaxf(a, p0[14]), p0[15]); c = __builtin_fmaxf(__builtin_fmaxf(c, p1[14]), p1[15]);
  const float m = __builtin_fmaxf(__builtin_fmaxf(a, b), __builtin_fmaxf(c, d));
  auto rr = __builtin_amdgcn_permlane32_swap(__float_as_uint(m), __float_as_uint(m), false, false);
  return __builtin_fmaxf(__uint_as_float(rr[0]), __uint_as_float(rr[1]));
}
#define SBGRP(P, B, kb, T) do { float z_[4], s_[4];                                                                          \
    _Pragma("unroll") for (int k_ = 0; k_ < 4; ++k_) { const float zz = P[(B) + k_];                                           \
      const float e_ = __builtin_amdgcn_exp2f(-__builtin_fabsf(zz)); const float l_ = __builtin_amdgcn_logf(1.0f + e_);        \
      float u_ = -(fmaxf(zz, 0.f) + l_); float zk = zz;                                                                         \
      if (needmask) { const bool msk_ = (kbase + (kb) + k_) >= qrow; u_ = msk_ ? 0.f : u_; zk = msk_ ? -INFINITY : zk; }        \
      z_[k_] = zk; s_[k_] = u_; }                                                                                               \
    s_[2] += s_[3]; s_[1] += s_[2]; s_[0] += s_[1]; T = s_[0];                                                                 \
    _Pragma("unroll") for (int k_ = 0; k_ < 4; ++k_) P[(B) + k_] = z_[k_] + s_[k_]; } while (0)
__device__ __forceinline__ void partialSB(f32x16& p0, f32x16& p1, float& R, int kbase, int qrow, bool needmask, int hi) {
  float T0[4], T1[4];
  const int h4 = 4 * hi;
  SBGRP(p1, 12, 32 + 24 + h4, T1[3]); SBGRP(p1, 8, 32 + 16 + h4, T1[2]); SBGRP(p1, 4, 32 + 8 + h4, T1[1]); SBGRP(p1, 0, 32 + h4, T1[0]);
  SBGRP(p0, 12, 24 + h4, T0[3]); SBGRP(p0, 8, 16 + h4, T0[2]); SBGRP(p0, 4, 8 + h4, T0[1]); SBGRP(p0, 0, h4, T0[0]);
  float off0[4], off1[4]; float X = R;
  const float selh = hi ? 0.f : 1.f;
#pragma unroll
  for (int g = 3; g >= 0; --g) { auto rr = __builtin_amdgcn_permlane32_swap(__float_as_uint(T1[g]), __float_as_uint(T1[g]), false, false);
    const float TL = __uint_as_float(rr[0]), TH = __uint_as_float(rr[1]); off1[g] = X + selh * TH; X = X + (TL + TH); }
#pragma unroll
  for (int g = 3; g >= 0; --g) { auto rr = __builtin_amdgcn_permlane32_swap(__float_as_uint(T0[g]), __float_as_uint(T0[g]), false, false);
    const float TL = __uint_as_float(rr[0]), TH = __uint_as_float(rr[1]); off0[g] = X + selh * TH; X = X + (TL + TH); }
  R = X;
#pragma unroll
  for (int r = 0; r < 16; ++r) { p1[r] += off1[r >> 2]; p0[r] += off0[r >> 2]; }
}
__device__ __forceinline__ void finishSB(f32x16& p0, f32x16& p1, bf16x8& pa0, bf16x8& pa1, bf16x8& pa2, bf16x8& pa3) {
#pragma unroll
  for (int r = 0; r < 16; ++r) p0[r] = __builtin_amdgcn_exp2f(p0[r]);
#pragma unroll
  for (int r = 0; r < 16; ++r) p1[r] = __builtin_amdgcn_exp2f(p1[r]);
  PK4(p0, 0, pa0); PK4(p0, 8, pa1); PK4(p1, 0, pa2); PK4(p1, 8, pa3);
}
template <int NQ>
__device__ __forceinline__ void qkt(f32x16& p0, f32x16& p1, const char* Ks, const bf16x8* qr, int r32, int hi, int kcolB) {
  p0 = f32x16{}; p1 = f32x16{};
#pragma unroll
  for (int d0 = 0; d0 < NQ; ++d0) { const int cb = kcolB + (d0 * 16 + hi * 8) * 2;
    bf16x8 b0 = *reinterpret_cast<const bf16x8*>(Ks + KSWZ(r32, cb));
    bf16x8 b1 = *reinterpret_cast<const bf16x8*>(Ks + KSWZ(32 + r32, cb));
    p0 = __builtin_amdgcn_mfma_f32_32x32x16_bf16(b0, qr[d0], p0, 0, 0, 0);
    p1 = __builtin_amdgcn_mfma_f32_32x32x16_bf16(b1, qr[d0], p1, 0, 0, 0); }
}
__device__ __forceinline__ void qkt_q(f32x16& p0, f32x16& p1, const char* Ks, const char* Qs, int r32, int hi, int kcolB) {
  p0 = f32x16{}; p1 = f32x16{};
#pragma unroll
  for (int d0 = 0; d0 < 4; ++d0) { const int cb = kcolB + (d0 * 16 + hi * 8) * 2;
    const bf16x8 q = *reinterpret_cast<const bf16x8*>(Qs + d0 * 1024);
    const bf16x8 b0 = *reinterpret_cast<const bf16x8*>(Ks + KSWZ(r32, cb));
    const bf16x8 b1 = *reinterpret_cast<const bf16x8*>(Ks + KSWZ(32 + r32, cb));
    p0 = __builtin_amdgcn_mfma_f32_32x32x16_bf16(b0, q, p0, 0, 0, 0);
    p1 = __builtin_amdgcn_mfma_f32_32x32x16_bf16(b1, q, p1, 0, 0, 0);
    if (d0 == 1) asm volatile("" ::: "memory"); }
}
template <int OFF> __device__ __forceinline__ bf16x8 lds_rd128(int a) { bf16x8 r; asm volatile("ds_read_b128 %0, %1 offset:%2" : "=&v"(r) : "v"(a), "i"(OFF) : "memory"); return r; }
template <int KOFF, int QB>
__device__ __forceinline__ void qkt_pipe(f32x16& p0, f32x16& p1, const int (&ka)[4], int qa) {
  bf16x8 q[3], k0[3], k1[3];
  q[0] = lds_rd128<QB>(qa);        k0[0] = lds_rd128<KOFF>(ka[0]); k1[0] = lds_rd128<KOFF + 8192>(ka[0]);
  q[1] = lds_rd128<QB + 1024>(qa); k0[1] = lds_rd128<KOFF>(ka[1]); k1[1] = lds_rd128<KOFF + 8192>(ka[1]);
  q[2] = lds_rd128<QB + 2048>(qa); k0[2] = lds_rd128<KOFF>(ka[2]); k1[2] = lds_rd128<KOFF + 8192>(ka[2]);
  asm volatile("s_waitcnt lgkmcnt(6)" ::: "memory"); SBAR();
  p0 = __builtin_amdgcn_mfma_f32_32x32x16_bf16(k0[0], q[0], f32x16{}, 0, 0, 0); p1 = __builtin_amdgcn_mfma_f32_32x32x16_bf16(k1[0], q[0], f32x16{}, 0, 0, 0); SBAR();
  q[0] = lds_rd128<QB + 3072>(qa); k0[0] = lds_rd128<KOFF>(ka[3]); k1[0] = lds_rd128<KOFF + 8192>(ka[3]);
  asm volatile("s_waitcnt lgkmcnt(6)" ::: "memory"); SBAR();
  p0 = __builtin_amdgcn_mfma_f32_32x32x16_bf16(k0[1], q[1], p0, 0, 0, 0); p1 = __builtin_amdgcn_mfma_f32_32x32x16_bf16(k1[1], q[1], p1, 0, 0, 0); SBAR();
  asm volatile("s_waitcnt lgkmcnt(3)" ::: "memory"); SBAR();
  p0 = __builtin_amdgcn_mfma_f32_32x32x16_bf16(k0[2], q[2], p0, 0, 0, 0); p1 = __builtin_amdgcn_mfma_f32_32x32x16_bf16(k1[2], q[2], p1, 0, 0, 0); SBAR();
  asm volatile("s_waitcnt lgkmcnt(0)" ::: "memory"); SBAR();
  p0 = __builtin_amdgcn_mfma_f32_32x32x16_bf16(k0[0], q[0], p0, 0, 0, 0); p1 = __builtin_amdgcn_mfma_f32_32x32x16_bf16(k1[0], q[0], p1, 0, 0, 0); SBAR();
}
__device__ __forceinline__ int v_st(int k, int c) { const int kk = (k & ~0xC) | ((k & 4) << 1) | ((k & 8) >> 1); return ((kk >> 3) * 4 + (c >> 5)) * 512 + ((kk & 7) * 32 + (c & 31)) * 2; }
__device__ __forceinline__ int v_rd_base(int lane) { return ((lane & 3) << 3) | (((lane >> 2) & 3) << 6) | (((lane >> 4) & 1) << 5) | (((lane >> 5) & 1) << 11); }
constexpr int v_rd_off(int d0, int ks, int half) { return d0 * 512 + ks * 4096 + half * 256; }
template <int OFF> __device__ __forceinline__ s16x4 tr_read(int vb) {
  s16x4 r; asm volatile("ds_read_b64_tr_b16 %0, %1 offset:%2" : "=&v"(r) : "v"(vb), "i"(OFF) : "memory"); return r;
}
template <int D0> __device__ __forceinline__ void pv_one(f32x16& od, int vb, bf16x8 pa0, bf16x8 pa1, bf16x8 pa2, bf16x8 pa3) {
  const s16x4 l0 = tr_read<v_rd_off(D0, 0, 0)>(vb), h0 = tr_read<v_rd_off(D0, 0, 1)>(vb), l1 = tr_read<v_rd_off(D0, 1, 0)>(vb), h1 = tr_read<v_rd_off(D0, 1, 1)>(vb);
  const s16x4 l2 = tr_read<v_rd_off(D0, 2, 0)>(vb), h2 = tr_read<v_rd_off(D0, 2, 1)>(vb), l3 = tr_read<v_rd_off(D0, 3, 0)>(vb), h3 = tr_read<v_rd_off(D0, 3, 1)>(vb);
  asm volatile("s_waitcnt lgkmcnt(0)" ::: "memory"); SBAR();
#define PKV(L, H) (bf16x8){L[0], L[1], L[2], L[3], H[0], H[1], H[2], H[3]}
  od = __builtin_amdgcn_mfma_f32_32x32x16_bf16(pa0, PKV(l0, h0), od, 0, 0, 0);
  od = __builtin_amdgcn_mfma_f32_32x32x16_bf16(pa1, PKV(l1, h1), od, 0, 0, 0);
  od = __builtin_amdgcn_mfma_f32_32x32x16_bf16(pa2, PKV(l2, h2), od, 0, 0, 0);
  od = __builtin_amdgcn_mfma_f32_32x32x16_bf16(pa3, PKV(l3, h3), od, 0, 0, 0);
#undef PKV
}
__device__ __forceinline__ void pv_d0(f32x16* o, int vb, bf16x8 pa0, bf16x8 pa1, bf16x8 pa2, bf16x8 pa3) {
  pv_one<0>(o[0], vb, pa0, pa1, pa2, pa3); pv_one<1>(o[1], vb, pa0, pa1, pa2, pa3); pv_one<2>(o[2], vb, pa0, pa1, pa2, pa3); pv_one<3>(o[3], vb, pa0, pa1, pa2, pa3);
}

struct VFrag { s16x4 l[4], h[4]; };
template <int KS> __device__ __forceinline__ void tr_group(VFrag& f, int vb) {
  f.l[0] = tr_read<v_rd_off(0, KS, 0)>(vb); f.h[0] = tr_read<v_rd_off(0, KS, 1)>(vb); f.l[1] = tr_read<v_rd_off(1, KS, 0)>(vb); f.h[1] = tr_read<v_rd_off(1, KS, 1)>(vb);
  f.l[2] = tr_read<v_rd_off(2, KS, 0)>(vb); f.h[2] = tr_read<v_rd_off(2, KS, 1)>(vb); f.l[3] = tr_read<v_rd_off(3, KS, 0)>(vb); f.h[3] = tr_read<v_rd_off(3, KS, 1)>(vb);
}
__device__ __forceinline__ void mma_group2(f32x16* oa, f32x16* ob, const VFrag& f, bf16x8 pa, bf16x8 pb) {
#define PKV(L, H) (bf16x8){L[0], L[1], L[2], L[3], H[0], H[1], H[2], H[3]}
  const bf16x8 v0 = PKV(f.l[0], f.h[0]), v1 = PKV(f.l[1], f.h[1]), v2 = PKV(f.l[2], f.h[2]), v3 = PKV(f.l[3], f.h[3]);
  asm volatile("v_mfma_f32_32x32x16_bf16 %0, %4, %5, %0\n\tv_mfma_f32_32x32x16_bf16 %1, %4, %6, %1\n\tv_mfma_f32_32x32x16_bf16 %2, %4, %7, %2\n\tv_mfma_f32_32x32x16_bf16 %3, %4, %8, %3"
               : "+v"(oa[0]), "+v"(oa[1]), "+v"(oa[2]), "+v"(oa[3]) : "v"(pa), "v"(v0), "v"(v1), "v"(v2), "v"(v3));
  asm volatile("v_mfma_f32_32x32x16_bf16 %0, %4, %5, %0\n\tv_mfma_f32_32x32x16_bf16 %1, %4, %6, %1\n\tv_mfma_f32_32x32x16_bf16 %2, %4, %7, %2\n\tv_mfma_f32_32x32x16_bf16 %3, %4, %8, %3"
               : "+v"(ob[0]), "+v"(ob[1]), "+v"(ob[2]), "+v"(ob[3]) : "v"(pb), "v"(v0), "v"(v1), "v"(v2), "v"(v3));
#undef PKV
}
__device__ __forceinline__ void pv_shared(f32x16* oa, f32x16* ob, int vb, const bf16x8 (&pa)[4], const bf16x8 (&pb)[4]) {
  VFrag fa, fb;
  tr_group<0>(fa, vb); tr_group<1>(fb, vb);
  asm volatile("s_waitcnt lgkmcnt(8)" ::: "memory"); SBAR(); mma_group2(oa, ob, fa, pa[0], pb[0]); SBAR();
  tr_group<2>(fa, vb);
  asm volatile("s_waitcnt lgkmcnt(8)" ::: "memory"); SBAR(); mma_group2(oa, ob, fb, pa[1], pb[1]); SBAR();
  tr_group<3>(fb, vb);
  asm volatile("s_waitcnt lgkmcnt(8)" ::: "memory"); SBAR(); mma_group2(oa, ob, fa, pa[2], pb[2]); SBAR();
  asm volatile("s_waitcnt lgkmcnt(0)" ::: "memory"); SBAR(); mma_group2(oa, ob, fb, pa[3], pb[3]); SBAR();
}

constexpr float SB_DEAD = -152.0f;
template <int MODE, typename SRC, bool EARLY>
__device__ __forceinline__ void attn_pass_simple(const bf16* __restrict__ Qw, const SRC& src, int NT, int nvis, int qrow, int kcolB, f32x16 (&o)[4], float& l_out, char* lds, bool active = true) {
  using St = Stage<typename SRC::T>;
  constexpr int NQ = MODE == 0 ? 4 : 8;
  int tid = tidx(); asm volatile("" : "+v"(tid));
  const int wid = __builtin_amdgcn_readfirstlane(tid >> 6), lane = tid & 63, r32 = lane & 31, hi = lane >> 5;
  char* V_lds = lds; char* K_lds = lds + 2 * SHM_V;
  float* ws = (float*)(lds + OFF_WS) + wid * 64; float* al_l = ws + 32;
  volatile PG8_LAS unsigned* vote = (volatile PG8_LAS unsigned*)(uintptr_t)(unsigned)(uintptr_t)(lds + OFF_VOTE);
  float m_reg = -1e30f, l_reg = 0.f, Rsb = 0.f; bf16x8 qr[NQ]; bool wdead = !active;
#pragma unroll
  for (int d0 = 0; d0 < 4; ++d0) o[d0] = f32x16{};
#pragma unroll
  for (int d0 = 0; d0 < NQ; ++d0) qr[d0] = *reinterpret_cast<const bf16x8*>(Qw + d0 * 16);
  const int sr = tid >> 4, sc = (tid & 15) * 8, vst0 = v_st(sr, sc), vst1 = v_st(32 + sr, sc);
  const int vb0 = (int)(uintptr_t)V_lds + v_rd_base(lane);
  const int qrow0 = __builtin_amdgcn_readfirstlane(qrow - r32);
  typename St::T vs0, vs1, ks0, ks1;
#define TT(s) (MODE == 1 ? (NT - 1 - (s)) : (s))
#define SLOAD1(s) do { const int ka_ = TT(s) * KVBLK + sr; vs0 = St::ld8(src.vrow(ka_) + sc); vs1 = St::ld8(src.vrow(ka_ + 32) + sc); ks0 = St::ld8(src.krow(ka_) + sc); ks1 = St::ld8(src.krow(ka_ + 32) + sc); } while (0)
#define SWRITE1(b) do { *(bf16x8*)(V_lds + (b) * SHM_V + vst0) = St::tobf(vs0); *(bf16x8*)(V_lds + (b) * SHM_V + vst1) = St::tobf(vs1); const int kc = sc * 2; \
    *(bf16x8*)(K_lds + (b) * SHM_K + KSWZ(sr, kc)) = St::tobf(ks0); *(bf16x8*)(K_lds + (b) * SHM_K + KSWZ(32 + sr, kc)) = St::tobf(ks1); } while (0)
  SLOAD1(0); asm volatile("s_waitcnt vmcnt(0)" ::: "memory"); SWRITE1(0); __syncthreads();
  for (int s = 0; s < NT; ++s) {
    const int b = s & 1; const bool more = s + 1 < NT;
    if (more) SLOAD1(s + 1);
    const bool work = MODE == 0 ? true : (active && !wdead && (TT(s) * KVBLK < qrow0 + 31));
    if (work) {
    f32x16 p0, p1; bf16x8 pa0, pa1, pa2, pa3;
    SBAR(); qkt<NQ>(p0, p1, K_lds + b * SHM_K, qr, r32, hi, kcolB);
    if (MODE == 0) {
      if (TT(s) >= nvis) {
#pragma unroll
        for (int r = 0; r < 16; ++r) { p0[r] = -1e30f; p1[r] = -1e30f; } }
      float al; partialSM(p0, p1, m_reg, al);
      if (__any(al < 1.f)) { if (hi == 0) al_l[r32] = al; asm volatile("s_waitcnt lgkmcnt(0)" ::: "memory");
#pragma unroll
        for (int d = 0; d < 4; ++d)
#pragma unroll
          for (int r = 0; r < 16; ++r) o[d][r] *= al_l[crow(r, hi)]; }
      finishSM(p0, p1, al, l_reg, pa0, pa1, pa2, pa3);
    } else {
      const int kb_ = TT(s) * KVBLK; partialSB(p0, p1, Rsb, kb_, qrow, (kb_ + KVBLK > qrow0), hi);
      finishSB(p0, p1, pa0, pa1, pa2, pa3);
    }
    SBAR(); pv_d0(o, vb0 + b * (int)SHM_V, pa0, pa1, pa2, pa3);
    }
    if (more) SWRITE1(b ^ 1);
    if (MODE == 1) wdead = !active || __all(Rsb < SB_DEAD);
    if (EARLY) { if (lane == 0) vote[b * 8 + wid] = wdead ? 1u : 0u; }
    __syncthreads();
    if (EARLY) { unsigned all = 1u;
#pragma unroll
      for (int w = 0; w < NW; ++w) all &= vote[b * 8 + w];
      if (all) break; }
  }
  l_out = l_reg;
  __syncthreads();
#undef TT
#undef SLOAD1
#undef SWRITE1
}

#define LBAR() do { asm volatile("s_waitcnt lgkmcnt(0)" ::: "memory"); __builtin_amdgcn_s_barrier(); asm volatile("" ::: "memory"); } while (0)
template <typename SRC>
__device__ __forceinline__ void attn_diff_pass(const bf16* __restrict__ Qw, const SRC& src, int NT, int nvis, f32x16 (&o1)[4], f32x16 (&o2)[4], float& l1_out, float& l2_out, char* lds) {
  int tid = tidx(); asm volatile("" : "+v"(tid));
  const int wid = __builtin_amdgcn_readfirstlane(tid >> 6), lane = tid & 63, r32 = lane & 31, hi = lane >> 5;
  char* V_lds = lds; char* K_lds = lds + 2 * SHM_V;
  float m1 = 0.f, l1 = 0.f, m2 = 0.f, l2 = 0.f;
#pragma unroll
  for (int d0 = 0; d0 < 4; ++d0) { o1[d0] = f32x16{}; o2[d0] = f32x16{}; }
  char* Qs = lds + OFF_Q + wid * 8192 + lane * 16;
  const int qsa = (int)(uintptr_t)Qs;
  bf16x8 qtmp[8];
#pragma unroll
  for (int d0 = 0; d0 < 8; ++d0) qtmp[d0] = *reinterpret_cast<const bf16x8*>(Qw + d0 * 16);
  const int vb0 = (int)(uintptr_t)V_lds + v_rd_base(lane);
  const int kad0 = (int)(uintptr_t)K_lds + KSWZ(r32, hi * 16);
  typedef int i32x4_ __attribute__((ext_vector_type(4)));
  const int dslot_delta = (int)OFF_DMA - (int)OFF_Q + wid * (1024 - 8192);
#define DSLOT() ((PG8_LAS i32x4_*)(uintptr_t)(unsigned)(qsa + dslot_delta))
  { int ko_[2], vo_[2];
#pragma unroll
    for (int i = 0; i < 2; ++i) { const int g = (2 * wid + i) * 64 + lane;
      ko_[i] = (g >> 4) * SRC::PITCH + ((g & 15) ^ ((g >> 4) & 7)) * 8;
      const int blk = g >> 5, kk = (blk >> 2) * 8 + ((g & 31) >> 2); vo_[i] = ((kk & ~0xC) | ((kk & 4) << 1) | ((kk & 8) >> 1)) * SRC::PITCH + (blk & 3) * 32 + (g & 3) * 8; }
    *DSLOT() = (i32x4_){2 * ko_[0], 2 * ko_[1], 2 * vo_[0], 2 * vo_[1]}; }
  const unsigned ldsK = (unsigned)(uintptr_t)K_lds + (unsigned)wid * 2048u, ldsV = (unsigned)(uintptr_t)V_lds + (unsigned)wid * 2048u;
#define KVDMA1(OFF_, BASE_, LDS_) asm volatile("s_mov_b32 m0, %2\n\ts_nop 0\n\tglobal_load_lds_dwordx4 %0, %1" :: "v"(OFF_), "s"((const char*)(BASE_)), "s"((unsigned)(LDS_)) : "memory")
#define KVDMA(s, B_) do { const i32x4_ of_ = *(volatile PG8_LAS i32x4_*)DSLOT(); \
      KVDMA1(of_.x, src.krow((s) * KVBLK), ldsK + (unsigned)((B_) * (int)SHM_K)); KVDMA1(of_.y, src.krow((s) * KVBLK), ldsK + (unsigned)((B_) * (int)SHM_K + 1024)); \
      KVDMA1(of_.z, src.vrow((s) * KVBLK), ldsV + (unsigned)((B_) * (int)SHM_V)); KVDMA1(of_.w, src.vrow((s) * KVBLK), ldsV + (unsigned)((B_) * (int)SHM_V + 1024)); } while (0)
#define QKSTEP(QOFF, KCOL, QMW) do { { int ka_[4]; _Pragma("unroll") for (int d0 = 0; d0 < 4; ++d0) ka_[d0] = (kad0 + b * (int)SHM_K) ^ (d0 * 32); \
        qkt_pipe<KCOL, (QOFF) * 1024>(p0, p1, ka_, qsa); } \
        \
      if (__builtin_expect(__any((QMW) != 0.f), 0)) {   \
      int lz_ = lane; asm volatile("" : "+v"(lz_)); const bool lo_ = lz_ < 32;     \
      const bf16x8 qm = __builtin_bit_cast(bf16x8, (u32x4){lo_ ? (pg8::cvt_pk_bf16(-(QMW), 0.f) & 0xffffu) : 0u, 0u, 0u, 0u}), kones = __builtin_bit_cast(bf16x8, (u32x4){lo_ ? 0x3f80u : 0u, 0u, 0u, 0u}); \
      p0 = __builtin_amdgcn_mfma_f32_32x32x16_bf16(kones, qm, p0, 0, 0, 0); p1 = __builtin_amdgcn_mfma_f32_32x32x16_bf16(kones, qm, p1, 0, 0, 0); } } while (0)
#define T1(QOFF, KCOL, MREG, LREG, O, QMW, PA) do { f32x16 p0, p1; \
    QKSTEP(QOFF, KCOL, QMW); \
    _Pragma("unroll") for (int r = 0; r < 16; ++r) { p0[r] = __builtin_amdgcn_exp2f(p0[r]); p1[r] = __builtin_amdgcn_exp2f(p1[r]); } \
    float ps = rowsum32(p0, p1); float al = 1.f; \
    if (__builtin_expect(__any(!(ps <= 1.0995116e12f)), 0)) { asm volatile("" ::: "memory"); \
      QKSTEP(QOFF, KCOL, QMW); \
      const float pmax = rowmax32(p0, p1); const float dw = fmaxf(pmax, 0.f); \
      const float mnew = __uint_as_float(pg8::cvt_pk_bf16(MREG + dw, 0.f) << 16); const float dd = mnew - MREG; al = __builtin_amdgcn_exp2f(-dd); MREG = mnew; \
      _Pragma("unroll") for (int r = 0; r < 16; ++r) { p0[r] = __builtin_amdgcn_exp2f(p0[r] - dd); p1[r] = __builtin_amdgcn_exp2f(p1[r] - dd); } \
      ps = rowsum32(p0, p1); \
      if (__any(al < 1.f)) { int ly_ = lane; asm volatile("" : "+v"(ly_)); const int hi_ = ly_ >> 5; float* al_l = (float*)(lds + OFF_WS) + wid * 64 + 32; if (hi_ == 0) al_l[ly_ & 31] = al; asm volatile("s_waitcnt lgkmcnt(0)" ::: "memory"); \
        _Pragma("unroll") for (int d = 0; d < 4; ++d) _Pragma("unroll") for (int r = 0; r < 16; ++r) O[d][r] *= al_l[crow(r, hi_)]; } } \
    LREG = LREG * al + ps; \
    PK4(p0, 0, PA[0]); PK4(p0, 8, PA[1]); PK4(p1, 0, PA[2]); PK4(p1, 8, PA[3]); } while (0)
  asm volatile("s_waitcnt lgkmcnt(0)" ::: "memory"); KVDMA(0, 0);
#pragma unroll
  for (int d0 = 0; d0 < 8; ++d0) *(bf16x8*)(Qs + d0 * 1024) = qtmp[d0];
  asm volatile("s_waitcnt vmcnt(0)" ::: "memory");
  LBAR();
  for (int s = 0; s < NT; ++s) {
    const int b = s & 1;
    if (s + 1 < NT) KVDMA(s + 1, b ^ 1);
    if (s < nvis) {
      bf16x8 paA[4], paB[4];
      T1(0, 0, m1, l1, o1, m1, paA);
      T1(4, 128, m2, l2, o2, m2, paB);
      asm volatile("s_waitcnt lgkmcnt(0)" ::: "memory"); SBAR();
      pv_shared(o1, o2, vb0 + b * (int)SHM_V, paA, paB);
    }
    asm volatile("s_waitcnt vmcnt(0)" ::: "memory");
    LBAR();
  }
  l1_out = l1; l2_out = l2;
#undef KVDMA
#undef KVDMA1
#undef QKSTEP
#undef T1
#undef DSLOT
}
#undef LBAR

struct UnitP { int type; int b, h, qb; };
struct Tensors {
  unsigned char* ws; KArgs A;
  __device__ __forceinline__ const bf16* QA() const { return (const bf16*)(ws + WS_QA); }   __device__ __forceinline__ const bf16* QB() const { return (const bf16*)(ws + WS_QB); }
  __device__ __forceinline__ const bf16* KA() const { return (const bf16*)(ws + WS_KA); }   __device__ __forceinline__ const bf16* VA() const { return (const bf16*)(ws + WS_VA); }
  __device__ __forceinline__ const bf16* KB() const { return (const bf16*)(ws + WS_KB); }   __device__ __forceinline__ const bf16* VB() const { return (const bf16*)(ws + WS_VB); }
  __device__ __forceinline__ bf16* OA() const { return (bf16*)(ws + WS_QA); }               __device__ __forceinline__ bf16* OB() const { return (bf16*)(ws + WS_QB); }
  __device__ __forceinline__ const float* cKA() const { return A->in.cdk; }                 __device__ __forceinline__ const float* cVA() const { return A->in.cdv; }
  __device__ __forceinline__ const float* cKB() const { return A->in.csk; }                 __device__ __forceinline__ const float* cVB() const { return A->in.csv; }
  __device__ __forceinline__ const float* nK(int i) const { return A->out + (size_t)MTOK * DM + 4 * (size_t)NPROMPT * 1024 + (size_t)i * NSAMPLE * 1024; }
  __device__ __forceinline__ bf16* scr() const { return (bf16*)A->out + (size_t)MTOK * DM; }
  __device__ __forceinline__ const float* subln_g() const { return A->in.subln_g; }         __device__ __forceinline__ const float* lamp() const { return (const float*)(ws + WS_LAM); }
};
constexpr int T_SEQ = 8192, T_PAST = 1024, T_DEC = 64, M_PROMPT = 32768;

__device__ __forceinline__ void store_o_rows(const f32x16 (&o)[4], bf16* Ow, char* lds, int wid, int lane_, bool store) {
  int lane = lane_; asm volatile("" : "+v"(lane));
  const int r32 = lane & 31, hi = lane >> 5;
  bf16* stg = (bf16*)(lds + wid * 8192);
#pragma unroll
  for (int d0 = 0; d0 < 4; ++d0)
#pragma unroll
    for (int r = 0; r < 16; ++r) stg[crow(r, hi) * 128 + d0 * 32 + r32] = (bf16)(cvtpk(o[d0][r], o[d0][r]) & 0xffffu);
  asm volatile("s_waitcnt lgkmcnt(0)" ::: "memory");
  if (store) {
    const int rr = lane >> 4, ch = lane & 15;
#pragma unroll
    for (int i = 0; i < 8; ++i) { const u32x4 v = *(const u32x4*)(stg + (i * 4 + rr) * 128 + ch * 8); *(u32x4*)(Ow + (size_t)(i * 4 + rr) * LD + ch * 8) = v; }
  }
}
template <int DUMMY> __device__ __forceinline__ void epilogue_diff(const UnitP& u, const Tensors& T, f32x16 (&o1)[4], f32x16 (&o2)[4], float l1, float l2, long qrow_g, bool store, char* lds);
template <typename SRC>
__device__ __forceinline__ void unit_diff(const UnitP& u, const Tensors& T, const SRC& src, long qrow_g  , int NT, int nvis, bool store, char* lds) {
  int tid = tidx(); asm volatile("" : "+v"(tid));
  const int wid = __builtin_amdgcn_readfirstlane(tid >> 6), lane = tid & 63, r32 = lane & 31, hi = lane >> 5;
  const bf16* Qrow = T.QA() + (size_t)(qrow_g + wid * QBLK + r32) * LD + u.h * 128 + hi * 8;
  f32x16 o1[4], o2[4]; float l1, l2;
  attn_diff_pass<SRC>(Qrow, src, NT, nvis, o1, o2, l1, l2, lds);
  epilogue_diff<0>(u, T, o1, o2, l1, l2, qrow_g, store, lds);
}
template <int DUMMY>
__device__ __forceinline__ void epilogue_diff(const UnitP& u, const Tensors& T, f32x16 (&o1)[4], f32x16 (&o2)[4], float l1, float l2, long qrow_g, bool store, char* lds) {
  int tid = tidx(); asm volatile("" : "+v"(tid));
  const int wid = __builtin_amdgcn_readfirstlane(tid >> 6), lane = tid & 63, r32 = lane & 31, hi = lane >> 5;
  float* wsl = (float*)(lds + OFF_WS) + wid * 64;
  const float lam = *T.lamp();
  if (hi == 0) { wsl[r32] = l1; wsl[32 + r32] = l2; } asm volatile("s_waitcnt lgkmcnt(0)" ::: "memory");
  float ss[16];
#pragma unroll
  for (int r = 0; r < 16; ++r) { const float ra = __builtin_amdgcn_rcpf(wsl[crow(r, hi)]), rb = lam * __builtin_amdgcn_rcpf(wsl[32 + crow(r, hi)]); float s = 0.f;
#pragma unroll
    for (int d0 = 0; d0 < 4; ++d0) { const float v = o1[d0][r] * ra - o2[d0][r] * rb; o1[d0][r] = v; s += v * v; }
    _Pragma("unroll") for (int m_ = 1; m_ < 32; m_ <<= 1) s += __int_as_float(__builtin_amdgcn_ds_bpermute((lane ^ m_) << 2, __float_as_int(s)));
    ss[r] = __builtin_amdgcn_rsqf(s * (1.0f / 128.0f) + 1e-6f) * 0.8f; }
#pragma unroll
  for (int d0 = 0; d0 < 4; ++d0) { const float g = T.subln_g()[d0 * 32 + r32];
#pragma unroll
    for (int r = 0; r < 16; ++r) o1[d0][r] = o1[d0][r] * ss[r] * g; }
  store_o_rows(o1, T.OA() + (size_t)(qrow_g + wid * QBLK) * LD + u.h * 128, lds, wid, lane, store);
  asm volatile("s_waitcnt vmcnt(0) lgkmcnt(0)" ::: "memory"); __syncthreads();
}
template <typename SRC, bool EARLY>
__device__ __forceinline__ void unit_sb(const UnitP& u, const Tensors& T, const SRC& src, long qrow_g, int qpos0  , int NT, bool store, bool active, char* lds) {
  int tid = tidx(); asm volatile("" : "+v"(tid));
  const int wid = __builtin_amdgcn_readfirstlane(tid >> 6), lane = tid & 63, r32 = lane & 31, hi = lane >> 5;
  const bf16* Qrow = T.QB() + (size_t)(qrow_g + wid * QBLK + r32) * LD + u.h * 128 + hi * 8;
  f32x16 o[4]; float l_dummy;
  attn_pass_simple<1, SRC, EARLY>(Qrow, src, NT, 0, qpos0 + wid * QBLK + r32, 0, o, l_dummy, lds, active);
  store_o_rows(o, T.OB() + (size_t)(qrow_g + wid * QBLK) * LD + u.h * 128, lds, wid, lane, store);
  asm volatile("s_waitcnt vmcnt(0) lgkmcnt(0)" ::: "memory"); __syncthreads();
}
#ifndef SB_EARLY_EXIT
#define SB_EARLY_EXIT true
#endif
__device__ __forceinline__ void run_unit(const UnitP& u, const Tensors& T, char* lds, bool dostore = true) {
  int tid0_ = tidx(); asm volatile("" : "+v"(tid0_));
  const int wid = __builtin_amdgcn_readfirstlane(tid0_ >> 6);
  if (u.type < 2) {
    const long row0 = (long)u.b * T_SEQ + u.qb * 256; const size_t kvoff = (size_t)u.b * T_SEQ * LD + u.h * 128;
    const int NT = 4 * u.qb + 4;
    if (u.type == 0) { KVLin s{T.KA() + kvoff, T.VA() + kvoff};
      unit_diff<KVLin>(u, T, s, row0, NT, 4 * u.qb + (wid >> 1) + 1, dostore, lds); }
    if (u.type == 1) { KVLin s{T.KB() + kvoff, T.VB() + kvoff};
      unit_sb<KVLin, SB_EARLY_EXIT>(u, T, s, row0, u.qb * 256, NT, dostore, true, lds); }
  } else {
    const long row0 = (long)M_PROMPT + u.b * T_DEC; const size_t coff = (size_t)u.b * T_PAST * LD + u.h * 128, noff = (size_t)u.b * T_DEC * LD + u.h * 128;
    const int NT = 18; const bool store = dostore && wid < 2;
    if (u.type == 2) {
      bf16* sk = T.scr() + (size_t)blockIdx.x * (2 * 1088 * 128); bf16* sv = sk + 1088 * 128;
      { int tid = tidx(); asm volatile("" : "+v"(tid));
        constexpr int NPIECE = 1088 * 16;
        for (int c0 = tid; c0 < NPIECE; c0 += 4 * 512) { f32x8 kx[4], vx[4];
#pragma unroll
          for (int j = 0; j < 4; ++j) { const int c = c0 + 512 * j; if (c < NPIECE) { const int row = c >> 4, c8 = (c & 15) * 8;
            const float* kr = row < T_PAST ? T.cKA() + coff + (size_t)row * LD : T.nK(0) + noff + (size_t)(row - T_PAST) * LD;
            const float* vr = row < T_PAST ? T.cVA() + coff + (size_t)row * LD : T.nK(1) + noff + (size_t)(row - T_PAST) * LD;
            kx[j] = *reinterpret_cast<const f32x8*>(kr + c8); vx[j] = *reinterpret_cast<const f32x8*>(vr + c8); } }
#pragma unroll
          for (int j = 0; j < 4; ++j) { const int c = c0 + 512 * j; if (c < NPIECE) { const int row = c >> 4, c8 = (c & 15) * 8;
            u32x4 wk = {cvtpk(kx[j][0], kx[j][1]), cvtpk(kx[j][2], kx[j][3]), cvtpk(kx[j][4], kx[j][5]), cvtpk(kx[j][6], kx[j][7])};
            u32x4 wv = {cvtpk(vx[j][0], vx[j][1]), cvtpk(vx[j][2], vx[j][3]), cvtpk(vx[j][4], vx[j][5]), cvtpk(vx[j][6], vx[j][7])};
            *(u32x4*)(sk + (size_t)row * 128 + c8) = wk; *(u32x4*)(sv + (size_t)row * 128 + c8) = wv; } } }
        asm volatile("s_waitcnt vmcnt(0)" ::: "memory"); __syncthreads();
        __builtin_amdgcn_fence(__ATOMIC_ACQUIRE, "agent"); asm volatile("s_waitcnt vmcnt(0)" ::: "memory"); }
      KVScr s{sk, sv};
      unit_diff<KVScr>(u, T, s, row0, 17, __builtin_amdgcn_readfirstlane(wid) < 2 ? 17 : 0, store, lds); }
    if (u.type == 3) { KVTwo s{T.cKB() + coff, T.cVB() + coff, T.nK(2) + noff, T.nK(3) + noff, T_PAST};
      unit_sb<KVTwo, SB_EARLY_EXIT>(u, T, s, row0, T_PAST, NT, store, __builtin_amdgcn_readfirstlane(wid) < 2, lds); }
  }
}
#undef KSWZ
#undef SBAR
#undef PK4
#undef SBGRP
}
#define GAS __attribute__((address_space(1)))
#define LAS __attribute__((address_space(3)))
typedef unsigned short bf16;
typedef unsigned v4u __attribute__((ext_vector_type(4)));
typedef float f32x4 __attribute__((ext_vector_type(4)));
typedef short bf16x8 __attribute__((ext_vector_type(8)));
typedef GAS unsigned gu32;
typedef GAS unsigned long long gu64;
#define RLX_AGENT __ATOMIC_RELAXED, __HIP_MEMORY_SCOPE_AGENT
#define LDS_WAIT() asm volatile("s_waitcnt lgkmcnt(0)" ::: "memory")
#define VM_WAIT() asm volatile("s_waitcnt vmcnt(0)" ::: "memory")
__device__ __forceinline__ unsigned long long rt() { return __builtin_amdgcn_s_memrealtime(); }
__device__ __forceinline__ unsigned f2bf(float f) { unsigned u = __builtin_bit_cast(unsigned, f); return (u + 0x7fffu + ((u >> 16) & 1u)) >> 16; }
__device__ __forceinline__ unsigned pk2(float lo, float hi) { return f2bf(lo) | (f2bf(hi) << 16); }

#define XB_TMO      128
#define XB_XCNT(j)  (256  + 64 * (j))
#define XB_XSUB(j)  (1280 + 64 * (j))
#define XB_XGEN(j)  (2304 + 64 * (j))
#define XB_TOP      3328
#define XB_TOPGEN   3392
#define XCD_BAR_WORDS 3456
#define XB_SPIN_CAP (1u << 18)

__device__ __forceinline__ unsigned xb_ld(unsigned* p)              { return __hip_atomic_load(p, __ATOMIC_RELAXED, __HIP_MEMORY_SCOPE_AGENT); }
__device__ __forceinline__ unsigned xb_add(unsigned* p, unsigned v) { return __hip_atomic_fetch_add(p, v, __ATOMIC_RELAXED, __HIP_MEMORY_SCOPE_AGENT); }
__device__ __forceinline__ unsigned xb_xcc_id() { return (unsigned)__builtin_amdgcn_s_getreg((3 << 11) | 20) & 0xFu; }
#define XB_SPIN(cond, bar) do { unsigned _sp = 0; while (cond) { __builtin_amdgcn_s_sleep(1); \
    if ((++_sp & 255u) == 0u) { if (xb_ld(&(bar)[XB_TMO])) break; if (_sp > XB_SPIN_CAP) { atomicAdd(&(bar)[XB_TMO], 1u); break; } } } } while (0)

struct XcdBarrier {
    unsigned* bar; unsigned x;
    volatile LAS unsigned* st;
};

__device__ __forceinline__ XcdBarrier xcd_barrier_post(unsigned* bar, volatile LAS unsigned* st) {
    XcdBarrier b; b.bar = bar; b.x = xb_xcc_id(); b.st = st;
    if (tidx() == 0) (void)xb_add(&bar[XB_XCNT(b.x)], 1u);
    return b;
}
__device__ __forceinline__ void xcd_barrier_complete(unsigned* bar, unsigned x, unsigned& nloc, unsigned& nx) {
    const unsigned G = gridDim.x * gridDim.y * gridDim.z;
    unsigned sum, cnt, mine, sp = 0u;
    for (;;) {
        sum = 0u; cnt = 0u; mine = 0u;
#pragma unroll
        for (unsigned j = 0; j < 16; ++j) { const unsigned c = xb_ld(&bar[XB_XCNT(j)]); sum += c; cnt += (c > 0u) ? 1u : 0u; mine = (j == x) ? c : mine; }
        if (sum == G) break;
        __builtin_amdgcn_s_sleep(1);
        if ((++sp & 255u) == 0u) { if (xb_ld(&bar[XB_TMO])) break; if (sp > XB_SPIN_CAP) { atomicAdd(&bar[XB_TMO], 1u); break; } }
    }
    nloc = mine > 0u ? mine : 1u; nx = cnt > 0u ? cnt : 1u;
}

__device__ __forceinline__ void xcd_barrier(const XcdBarrier& b) {
    asm volatile("s_waitcnt vmcnt(0)" ::: "memory");
    __syncthreads();
    if (tidx() == 0) {
        unsigned* bar = b.bar;
        __builtin_amdgcn_s_waitcnt(0);
        unsigned nloc = b.st[0], nx = b.st[1];
        if (nloc == 0u) { xcd_barrier_complete(bar, b.x, nloc, nx); b.st[0] = nloc; b.st[1] = nx; }
        const unsigned old = xb_add(&bar[XB_XSUB(b.x)], 1u);
        const unsigned gen = old / nloc;
        if (old + 1u == (gen + 1u) * nloc) {
            __builtin_amdgcn_fence(__ATOMIC_RELEASE, "agent");
            asm volatile("s_waitcnt vmcnt(0)" ::: "memory");
            const unsigned og = xb_add(&bar[XB_TOP], 1u);
            const unsigned tg = og / nx;
            if (og + 1u == (tg + 1u) * nx) xb_add(&bar[XB_TOPGEN], 1u);
            else XB_SPIN(xb_ld(&bar[XB_TOPGEN]) == tg, bar);
            __builtin_amdgcn_fence(__ATOMIC_ACQUIRE, "agent");
            xb_add(&bar[XB_XGEN(b.x)], 1u);
            asm volatile("s_waitcnt vmcnt(0)" ::: "memory");
        } else {
            XB_SPIN(xb_ld(&bar[XB_XGEN(b.x)]) == gen, bar);
            __builtin_amdgcn_fence(__ATOMIC_ACQUIRE, "agent");
            asm volatile("s_waitcnt vmcnt(0)" ::: "memory");
        }
    }
    __syncthreads();
}

static_assert(WAVETAB_OFF == MISC_OFF + 128 && WAVETAB_OFF + 256 <= (int)att::OFF_WS && (int)att::OFF_DMA + 512 * 16 <= LDS_BYTES && att::OFF_DMA % 16 == 0, "LDS map");
static_assert(att::SHM_ATTN <= RING_BYTES, "attention scratch fits the ring");

__device__ __forceinline__ float wave_sum(float v) {
#pragma unroll
    for (int o = 1; o < 64; o <<= 1) v += __shfl_xor(v, o);
    return v;
}
__device__ __forceinline__ void transpose_item(const float* W, int K, int N, bf16* WT, int k0, int n0, int drow0, LAS float* scr, int lane, const float* gk) {
    { const int ks = lane >> 3, n4 = (lane & 7) * 4; f32x4 w[8];
#pragma unroll
      for (int i = 0; i < 8; ++i) w[i] = *(const GAS f32x4*)(W + (size_t)(k0 + i * 8 + ks) * N + n0 + n4);
      if (gk) {
#pragma unroll
        for (int i = 0; i < 8; ++i) w[i] = w[i] * gk[k0 + i * 8 + ks]; }
#pragma unroll
      for (int i = 0; i < 8; ++i) { LAS float* d = scr + (i * 8 + ks) * 33 + n4; d[0] = w[i].x; d[1] = w[i].y; d[2] = w[i].z; d[3] = w[i].w; } }
    LDS_WAIT(); asm volatile("" ::: "memory");
    const int c = lane & 7;
#pragma unroll
    for (int j = 0; j < 4; ++j) { const int n = (lane >> 3) + 8 * j; const LAS float* s = scr + (8 * c) * 33 + n;
        v4u o; o.x = pk2(s[0 * 33], s[1 * 33]); o.y = pk2(s[2 * 33], s[3 * 33]); o.z = pk2(s[4 * 33], s[5 * 33]); o.w = pk2(s[6 * 33], s[7 * 33]);
        *(GAS v4u*)(WT + (size_t)(drow0 + n) * K + k0 + 8 * c) = o; }
    LDS_WAIT(); asm volatile("" ::: "memory");
}
__device__ __forceinline__ void transpose_item8(const float* W, unsigned char* WT8, int item, LAS float* scr, int lane) {
    const int kb = item >> 6, nb = item & 63, k0 = 64 * kb, n0 = 32 * nb; const int c = lane & 7;
    if (kb >= DFF / 64) {
#pragma unroll
        for (int j = 0; j < 4; ++j) { const int n = (lane >> 3) + 8 * j; *(GAS unsigned long long*)(WT8 + (size_t)(n0 + n) * pg8::ACT8_LD + k0 + 8 * c) = 0ull; }
        return; }
    { const int ks = lane >> 3, n4 = (lane & 7) * 4; f32x4 w[8];
#pragma unroll
      for (int i = 0; i < 8; ++i) w[i] = *(const GAS f32x4*)(W + (size_t)(k0 + i * 8 + ks) * DM + n0 + n4);
#pragma unroll
      for (int i = 0; i < 8; ++i) { LAS float* d = scr + (i * 8 + ks) * 33 + n4; d[0] = w[i].x; d[1] = w[i].y; d[2] = w[i].z; d[3] = w[i].w; } }
    LDS_WAIT(); asm volatile("" ::: "memory");
#pragma unroll
    for (int j = 0; j < 4; ++j) { const int n = (lane >> 3) + 8 * j; const LAS float* s = scr + (8 * c) * 33 + n; constexpr float SC = pg8::W8_SCALE;
        const unsigned lo = pg8::pk4_fp8(s[0 * 33] * SC, s[1 * 33] * SC, s[2 * 33] * SC, s[3 * 33] * SC), hi = pg8::pk4_fp8(s[4 * 33] * SC, s[5 * 33] * SC, s[6 * 33] * SC, s[7 * 33] * SC);
        *(GAS unsigned long long*)(WT8 + (size_t)(n0 + n) * pg8::ACT8_LD + k0 + 8 * c) = (unsigned long long)lo | ((unsigned long long)hi << 32); }
    LDS_WAIT(); asm volatile("" ::: "memory");
}
__device__ __forceinline__ void transpose_matrix_item(const float* W, int K, int N, bf16* WT, int row_off, int gu, int item, LAS float* scr, int lane, const float* gk = nullptr) {
    const int nblk = N / 32, kb = item / nblk, nb = item % nblk, k0 = 64 * kb, n0 = 32 * nb;
    const int drow0 = gu == 0 ? row_off + n0 : 256 * (n0 >> 7) + (n0 & 127) + (gu == 2 ? 128 : 0);
    transpose_item(W, K, N, WT, k0, n0, drow0, scr, lane, gk);
}
__device__ __forceinline__ f32x4 bf4(unsigned long long w) { const unsigned lo = (unsigned)w, hi = (unsigned)(w >> 32);
    return (f32x4){__uint_as_float(lo << 16), __uint_as_float(lo & 0xffff0000u), __uint_as_float(hi << 16), __uint_as_float(hi & 0xffff0000u)}; }
template <bool HAS_D, bool RES_BF, bool OUT_F32>
__device__ __forceinline__ void thin_row(const void* res, const bf16* d, float coef, const float* gpost, float* out_f32, bf16* hb, float* rs_out, int lane) {
    f32x4 v[8];
    if (RES_BF) { const GAS unsigned long long* xr = (const GAS unsigned long long*)res + lane;
#pragma unroll
        for (int j = 0; j < 8; ++j) v[j] = bf4(__builtin_nontemporal_load(xr + 64 * j)); }
    else { const GAS f32x4* xr = (const GAS f32x4*)res + lane;
#pragma unroll
        for (int j = 0; j < 8; ++j) v[j] = __builtin_nontemporal_load(xr + 64 * j); }
    if (HAS_D) {
        const GAS unsigned long long* dr = (const GAS unsigned long long*)d + lane;
        f32x4 dv[8]; float s = 0.f;
#pragma unroll
        for (int j = 0; j < 8; ++j) { dv[j] = bf4(__builtin_nontemporal_load(dr + 64 * j));
            s += (dv[j].x * dv[j].x + dv[j].y * dv[j].y) + (dv[j].z * dv[j].z + dv[j].w * dv[j].w); }
        const float rstd = coef / sqrtf(wave_sum(s) * (1.f / DM) + EPS);
        const GAS f32x4* gp = (const GAS f32x4*)gpost + lane;
#pragma unroll
        for (int j = 0; j < 8; ++j) { const f32x4 g = gp[64 * j]; v[j] = v[j] + dv[j] * g * rstd; }
    }
    if (OUT_F32) { GAS f32x4* orow = (GAS f32x4*)out_f32 + lane;
#pragma unroll
        for (int j = 0; j < 8; ++j) __builtin_nontemporal_store(v[j], orow + 64 * j); }
    else {
        float s2 = 0.f;
#pragma unroll
        for (int j = 0; j < 8; ++j) s2 += (v[j].x * v[j].x + v[j].y * v[j].y) + (v[j].z * v[j].z + v[j].w * v[j].w);
        GAS unsigned long long* o8 = (GAS unsigned long long*)hb + lane;
#pragma unroll
        for (int j = 0; j < 8; ++j) o8[64 * j] = (unsigned long long)pk2(v[j].x, v[j].y) | ((unsigned long long)pk2(v[j].z, v[j].w) << 32);
        const float rstd = 1.f / sqrtf(wave_sum(s2) * (1.f / DM) + EPS);
        if (lane == 0) *rs_out = rstd;
    }
}
__device__ __forceinline__ void unit_decode(int u, att::UnitP& p) {
    if (u < 1024) { p.type = 0; p.b = u >> 8; p.h = (u >> 5) & 7; p.qb = u & 31; }
    else if (u < 2048) { const int v = u - 1024; p.type = 1; p.b = v >> 8; p.h = (v >> 5) & 7; p.qb = v & 31; }
    else if (u < 2304) { const int v = u - 2048; p.type = 2; p.b = v >> 3; p.h = v & 7; p.qb = 0; }
    else { const int v = u - 2304; p.type = 3; p.b = v >> 3; p.h = v & 7; p.qb = 0; }
}
__device__ __forceinline__ int unit_at(int p) {
    if (p < 864) return (p & 31) * 32 + 31 - (p >> 5);
    if (p < 1120) return 2048 + (p - 864);
    if (p < 1280) return ((p - 1120) & 31) * 32 + 4 - ((p - 1120) >> 5);
    if (p < 1952) return 1024 + ((p - 1280) & 31) * 32 + 31 - ((p - 1280) >> 5);
    if (p < 2208) return 2304 + (p - 1952);
    return 1024 + ((p - 2208) & 31) * 32 + 10 - ((p - 2208) >> 5);
}
constexpr int N_SIDE = 64;
__device__ __forceinline__ KArgs kargs() { KArgs p = (KArgs)__builtin_amdgcn_kernarg_segment_ptr(); asm volatile("" : "+s"(p)); return p; }
#define ENV() KArgs A_ = kargs(); unsigned char* const ws = A_->ws; (void)ws; const int G = (int)gridDim.x, bx = (int)blockIdx.x; (void)G; (void)bx; \
    int tid = tidx(); asm volatile("" : "+v"(tid)); const int lane = tid & 63, wave = __builtin_amdgcn_readfirstlane(tid >> 6); (void)lane; (void)wave; \
    const int vcu = (G % 8 == 0) ? (bx % 8) * (G / 8) + bx / 8 : bx; const int gw = vcu * NWAVES + wave, NGW = G * NWAVES; (void)gw; (void)NGW
#define WSP(T, off) ((T*)(ws + (off)))

__global__ void __launch_bounds__(NWAVES * 64, 2) fwd_kernel(Args args) {
    extern __shared__ __attribute__((aligned(16))) unsigned char lds[];
    LAS unsigned char* ldsl = (LAS unsigned char*)lds;
    volatile LAS unsigned* MISC = (volatile LAS unsigned*)(ldsl + MISC_OFF);
    for (int u = threadIdx.x; u < (LDS_BYTES - LDSCTL_OFF) / 4; u += NWAVES * 64) ((LAS unsigned*)(ldsl + LDSCTL_OFF))[u] = 0u;
    __syncthreads();
    if ((threadIdx.x & 63) == 0) ((LAS int*)(ldsl + WAVETAB_OFF))[__builtin_amdgcn_s_getreg(0x2804)] = (int)(threadIdx.x >> 6);
    __syncthreads();
    XcdBarrier bar = xcd_barrier_post((unsigned*)((gu32*)(args.ws + WS_CTL) + CW_BAR), MISC + 8);

    {
        ENV();
        LAS float* scr = (LAS float*)(ldsl + RING_OFF + wave * 16384);
        bf16* WIN_T = WSP(bf16, WS_WIN); bf16* F1GU = WSP(bf16, WS_F1GU); bf16* F1D = WSP(bf16, WS_F1D); bf16* XN = WSP(bf16, WS_XN);
        constexpr int I_WIN = (DM / 64) * (INCOLS / 32), I_GU = (DM / 64) * (DFF / 32), I_DN = (DFF / 64) * (DM / 32);
        constexpr int NITEMS = I_WIN + 2 * I_GU + I_DN;
        for (int it = gw; it < NITEMS; it += NGW) {
            int r = it;
            if (r < I_GU) { transpose_matrix_item(A_->in.f1g, DM, DFF, F1GU, 0, 1, r, scr, lane, A_->in.n1a); continue; } r -= I_GU;
            if (r < I_GU) { transpose_matrix_item(A_->in.f1u, DM, DFF, F1GU, 0, 2, r, scr, lane, A_->in.n1a); continue; } r -= I_GU;
            if (r < I_DN) { transpose_matrix_item(A_->in.f1d, DFF, DM, F1D, 0, 0, r, scr, lane); continue; } r -= I_DN;
            transpose_matrix_item(A_->in.w_in, DM, INCOLS, WIN_T, 0, 0, r, scr, lane, A_->in.nma);
        }
        { const float* xp = A_->in.x_prompt; const float* xs = A_->in.x_sample; float* RS = WSP(float, WS_RSTD);
          for (int m = gw; m < MTOK; m += NGW) {
            const float* xr = m < NPROMPT ? xp + (size_t)m * DM : xs + (size_t)(m - NPROMPT) * DM;
            thin_row<false, false, false>(xr, nullptr, 0.f, nullptr, nullptr, XN + (size_t)m * DM, RS + m, lane); } }
        if (bx == 0 && wave == 0) {
            const float s1 = wave_sum(A_->in.lq1[lane] * A_->in.lk1[lane]), s2 = wave_sum(A_->in.lq2[lane] * A_->in.lk2[lane]);
            if (lane == 0) *WSP(float, WS_LAM) = __expf(s1) - __expf(s2) + 0.2f;
        }
    }
    xcd_barrier(bar);

    { ENV(); pg8::Gemm g{WSP(bf16, WS_XN), WSP(bf16, WS_F1GU), MTOK, 2 * DFF, DM}; pg8::StaticOrder S; S.init(MTOK, 2 * DFF, G, bx);
      pg8::EpiSwiGLU E{WSP(bf16, WS_BIG), DFF, WSP(float, WS_RSTD)};
      pg8::gemm_phase<pg8::EpiSwiGLU, pg8::StaticOrder, true, true>(ldsl + RING_OFF, g, S, E); }
    xcd_barrier(bar);
    { ENV(); pg8::Gemm g{WSP(bf16, WS_BIG), WSP(bf16, WS_F1D), NPROMPT, DM, DFF}; pg8::StaticOrder S; S.init(NPROMPT, DM, G, bx);
      pg8::EpiPlain E{WSP(bf16, WS_D), DM};
      pg8::gemm_phase<pg8::EpiPlain, pg8::StaticOrder, true, true>(ldsl + RING_OFF, g, S, E); }
    xcd_barrier(bar);
    { ENV();
      if (bx < N_SIDE) { pg8::Gemm g{WSP(bf16, WS_BIG), WSP(bf16, WS_F1D), MTOK, DM, DFF}; pg8::SampleOrder S{DM / 256, N_SIDE, bx};
        pg8::EpiPlain E{WSP(bf16, WS_D), DM};
        pg8::gemm_phase<pg8::EpiPlain, pg8::SampleOrder, true, true>(ldsl + RING_OFF, g, S, E); }
      else { const float* xp = A_->in.x_prompt; const float* gpo = A_->in.n1b; bf16* DB = WSP(bf16, WS_D); bf16* XN = WSP(bf16, WS_XN); float* RS = WSP(float, WS_RSTD);
        for (int m = (bx - N_SIDE) * NWAVES + wave; m < NPROMPT; m += (G - N_SIDE) * NWAVES)
          thin_row<true, true, false>(XN + (size_t)m * DM, DB + (size_t)m * DM, 0.5f, gpo, nullptr, XN + (size_t)m * DM, RS + m, lane); } }
    xcd_barrier(bar);
    { ENV(); const float* xs = A_->in.x_sample; const float* gpo = A_->in.n1b; bf16* DB = WSP(bf16, WS_D); bf16* XN = WSP(bf16, WS_XN); float* RS = WSP(float, WS_RSTD);
      for (int m = NPROMPT + gw; m < MTOK; m += NGW)
        thin_row<true, true, false>(XN + (size_t)m * DM, DB + (size_t)m * DM, 0.5f, gpo, nullptr, XN + (size_t)m * DM, RS + m, lane); }
    xcd_barrier(bar);
    { ENV(); pg8::Gemm g{WSP(bf16, WS_XN), WSP(bf16, WS_WIN), MTOK, INCOLS, DM}; pg8::StaticOrder S; S.init(MTOK, INCOLS, G, bx);
      float* okA_p = A_->out + (size_t)MTOK * DM;
      float* ovA_p = okA_p + (size_t)NPROMPT * 1024; float* okB_p = ovA_p + (size_t)NPROMPT * 1024; float* ovB_p = okB_p + (size_t)NPROMPT * 1024;
      float* okA_s = ovB_p + (size_t)NPROMPT * 1024; float* ovA_s = okA_s + (size_t)NSAMPLE * 1024; float* okB_s = ovA_s + (size_t)NSAMPLE * 1024; float* ovB_s = okB_s + (size_t)NSAMPLE * 1024;
      pg8::EpiWin E{WSP(bf16, WS_QA), WSP(bf16, WS_KA), WSP(bf16, WS_VA), WSP(bf16, WS_QB), WSP(bf16, WS_KB), WSP(bf16, WS_VB), WSP(bf16, WS_SGA), WSP(bf16, WS_SGB),
                    okA_p, ovA_p, okB_p, ovB_p, okA_s, ovA_s, okB_s, ovB_s, 0.18033688011112042f, 0.12751743082459868f, WSP(float, WS_RSTD)};
      pg8::gemm_phase<pg8::EpiWin, pg8::StaticOrder, true, true>(ldsl + RING_OFF, g, S, E);
      constexpr int NLAST = (MTOK / 256) * (INCOLS / 256) - 21 * 256;
      if (G == 256 ? bx >= NLAST : true) {
        LAS float* scr = (LAS float*)(ldsl + RING_OFF + wave * 16384);
        bf16* F2GU = WSP(bf16, WS_F2GU); bf16* F2D = WSP(bf16, WS_F2D); bf16* WAB = WSP(bf16, WS_WAB); bf16* WO_T = WSP(bf16, WS_WO);
        constexpr int I_GU = (DM / 64) * (DFF / 32), I_DN = (pg8::ACT8_LD / 64) * (DM / 32), I_UP = (1024 / 64) * (DM / 32), I_WO = (DM / 64) * (DM / 32);
        constexpr int NLATE = 2 * I_GU + I_DN + 2 * I_UP + I_WO;
        const int first = G == 256 ? (bx - NLAST) * NWAVES + wave : gw, stride = G == 256 ? (G - NLAST) * NWAVES : NGW;
        for (int it = first; it < NLATE; it += stride) {
            int r = it;
            if (r < I_GU) { transpose_matrix_item(A_->in.f2g, DM, DFF, F2GU, 0, 1, r, scr, lane, A_->in.n2a); continue; } r -= I_GU;
            if (r < I_GU) { transpose_matrix_item(A_->in.f2u, DM, DFF, F2GU, 0, 2, r, scr, lane, A_->in.n2a); continue; } r -= I_GU;
            if (r < I_DN) { transpose_item8(A_->in.f2d, (unsigned char*)F2D, r, scr, lane); continue; } r -= I_DN;
            if (r < I_UP) { transpose_matrix_item(A_->in.w_up_a, 1024, DM, WAB, 0, 0, r, scr, lane); continue; } r -= I_UP;
            if (r < I_UP) { transpose_matrix_item(A_->in.w_up_b, 1024, DM, WAB, 2048, 0, r, scr, lane); continue; } r -= I_UP;
            transpose_matrix_item(A_->in.w_o, DM, DM, WO_T, 0, 0, r, scr, lane);
        } } }
    xcd_barrier(bar);
    {
        for (;;) {
            ENV();
            if (tid == 0) MISC[16] = __hip_atomic_fetch_add((gu32*)(ws + WS_CTL) + CW_QUEUE, 1u, __ATOMIC_RELAXED, __HIP_MEMORY_SCOPE_AGENT);
            __syncthreads();
            const unsigned qi = MISC[16];
            __syncthreads();
            if (qi >= (unsigned)N_UNITS) break;
            att::Tensors T{ws, A_};
            att::UnitP up; unit_decode(unit_at((int)qi), up);
            att::run_unit(up, T, (char*)lds + RING_OFF);
        }
    }
    xcd_barrier(bar);
    { ENV(); pg8::Gemm g{WSP(bf16, WS_QA), WSP(bf16, WS_WAB), 2 * MTOK, 4096, 1024}; pg8::UpOrder S; S.init(G, bx);
      pg8::EpiUpGate E{WSP(bf16, WS_SGA), WSP(bf16, WS_SGB), (bf16*)A_->out};
      pg8::gemm_phase<pg8::EpiUpGate, pg8::UpOrder, true, true>(ldsl + RING_OFF, g, S, E); }
    xcd_barrier(bar);
    { ENV(); pg8::Gemm g{(const bf16*)A_->out, WSP(bf16, WS_WO), MTOK, DM, DM}; pg8::StaticOrder S; S.init(MTOK, DM, G, bx);
      pg8::EpiPlain E{WSP(bf16, WS_D), DM};
      pg8::gemm_phase<pg8::EpiPlain, pg8::StaticOrder, true, true>(ldsl + RING_OFF, g, S, E); }
    xcd_barrier(bar);
    { ENV(); const float* gpo = A_->in.nmb; bf16* DB = WSP(bf16, WS_D); bf16* XN = WSP(bf16, WS_XN); float* RS = WSP(float, WS_RSTD);
      for (int m = gw; m < MTOK; m += NGW)
        thin_row<true, true, false>(XN + (size_t)m * DM, DB + (size_t)m * DM, 1.0f, gpo, nullptr, XN + (size_t)m * DM, RS + m, lane); }
    xcd_barrier(bar);
    { ENV(); pg8::Gemm g{WSP(bf16, WS_XN), WSP(bf16, WS_F2GU), MTOK, 2 * DFF, DM}; pg8::StaticOrder S; S.init(MTOK, 2 * DFF, G, bx);
      pg8::EpiSwiGLU8 E{WSP(unsigned char, WS_BIG), WSP(float, WS_RSTD)};
      pg8::gemm_phase<pg8::EpiSwiGLU8, pg8::StaticOrder, true, true>(ldsl + RING_OFF, g, S, E); }
    xcd_barrier(bar);
    { ENV(); pg8::Gemm g{WSP(bf16, WS_BIG), WSP(bf16, WS_F2D), NPROMPT, DM, pg8::ACT8_LD / 2}; pg8::StaticOrder S; S.init(NPROMPT, DM, G, bx);
      pg8::EpiPlainS E{WSP(bf16, WS_D), DM, 1.f / (pg8::ACT8_SCALE * pg8::W8_SCALE)};
      pg8::gemm_phase<pg8::EpiPlainS, pg8::StaticOrder, true, true, true>(ldsl + RING_OFF, g, S, E); }
    xcd_barrier(bar);
    { ENV();
      if (bx < N_SIDE) { pg8::Gemm g{WSP(bf16, WS_BIG), WSP(bf16, WS_F2D), MTOK, DM, pg8::ACT8_LD / 2}; pg8::SampleOrder S{DM / 256, N_SIDE, bx};
        pg8::EpiPlainS E{WSP(bf16, WS_D), DM, 1.f / (pg8::ACT8_SCALE * pg8::W8_SCALE)};
        pg8::gemm_phase<pg8::EpiPlainS, pg8::SampleOrder, true, true, true>(ldsl + RING_OFF, g, S, E); }
      else { const float* gpo = A_->in.n2b; float* out_y = A_->out; bf16* DB = WSP(bf16, WS_D); const bf16* XN = WSP(bf16, WS_XN);
        for (int m = (bx - N_SIDE) * NWAVES + wave; m < NPROMPT; m += (G - N_SIDE) * NWAVES)
          thin_row<true, true, true>(XN + (size_t)m * DM, DB + (size_t)m * DM, 0.5f, gpo, out_y + (size_t)m * DM, nullptr, nullptr, lane); } }
    xcd_barrier(bar);
    { ENV(); const float* gpo = A_->in.n2b; float* out_y = A_->out; bf16* DB = WSP(bf16, WS_D); const bf16* XN = WSP(bf16, WS_XN);
      for (int m = NPROMPT + gw; m < MTOK; m += NGW)
        thin_row<true, true, true>(XN + (size_t)m * DM, DB + (size_t)m * DM, 0.5f, gpo, out_y + (size_t)m * DM, nullptr, nullptr, lane); }
}

extern "C" void kernel_launch(void* const* d_in, const int* in_sizes, int n_in, void* d_out, int out_size, void* d_ws, size_t ws_size, hipStream_t stream) {
    static int grid = 0;
    if (grid == 0) {
        const long want_out = (long)MTOK * DM + 4L * MTOK * 1024;
        if (n_in != 27 || in_sizes[0] != NPROMPT * DM || in_sizes[1] != NSAMPLE * DM || (long)out_size != want_out || ws_size < WS_END) {
            fprintf(stderr, "kernel_launch: shape mismatch: n_in %d in0 %d in1 %d out %d (want %ld) ws %zu (need %zu); nothing launched\n", n_in, n_in > 0 ? in_sizes[0] : -1, n_in > 1 ? in_sizes[1] : -1, out_size, want_out, ws_size, (size_t)WS_END);
            grid = -1; return; }
        int dev = 0, cus = 0, per_cu = 0;
        if (hipGetDevice(&dev) != hipSuccess || hipDeviceGetAttribute(&cus, hipDeviceAttributeMultiprocessorCount, dev) != hipSuccess) { fprintf(stderr, "kernel_launch: device query failed\n"); grid = -1; return; }
        if (hipFuncSetAttribute((const void*)fwd_kernel, hipFuncAttributeMaxDynamicSharedMemorySize, LDS_BYTES) != hipSuccess) { fprintf(stderr, "kernel_launch: hipFuncSetAttribute failed\n"); grid = -1; return; }
        if (hipOccupancyMaxActiveBlocksPerMultiprocessor(&per_cu, (const void*)fwd_kernel, NWAVES * 64, LDS_BYTES) != hipSuccess || per_cu < 1) {
            fprintf(stderr, "kernel_launch: occupancy query reports %d workgroups per CU; nothing launched\n", per_cu); (void)hipGetLastError(); grid = -1; return; }
        (void)hipGetLastError();
        grid = cus;
    }
    if (grid < 0) return;
    if (hipMemsetAsync((char*)d_ws + WS_CTL, 0, CTL_ZERO_BYTES, stream) != hipSuccess) { fprintf(stderr, "kernel_launch: hipMemsetAsync failed\n"); return; }
    Args a{};
    const float* const* p = (const float* const*)d_in;
    a.in.x_prompt = p[0]; a.in.x_sample = p[1]; a.in.cdk = p[2]; a.in.cdv = p[3]; a.in.csk = p[4]; a.in.csv = p[5]; a.in.w_in = p[6]; a.in.w_up_a = p[7]; a.in.w_up_b = p[8]; a.in.w_o = p[9];
    a.in.lq1 = p[10]; a.in.lk1 = p[11]; a.in.lq2 = p[12]; a.in.lk2 = p[13]; a.in.subln_g = p[14];
    a.in.n1a = p[15]; a.in.n1b = p[16]; a.in.nma = p[17]; a.in.nmb = p[18]; a.in.n2a = p[19]; a.in.n2b = p[20];
    a.in.f1g = p[21]; a.in.f1u = p[22]; a.in.f1d = p[23]; a.in.f2g = p[24]; a.in.f2u = p[25]; a.in.f2d = p[26];
    a.out = (float*)d_out; a.ws = (unsigned char*)d_ws;
    hipLaunchKernelGGL(fwd_kernel, dim3(grid), dim3(NWAVES * 64), LDS_BYTES, stream, a);
    const hipError_t le = hipPeekAtLastError();
    if (le != hipSuccess) fprintf(stderr, "kernel_launch: launch failed: %s\n", hipGetErrorName(le));
}
```
